# Optimizing an MI355X kernel written in HIP

```python
import math
import jax, jax.numpy as jnp
from jax import lax
import numpy as np

D_MODEL = 1024
BATCH = 16
SEQ = 2048
DEPTH = 1

MLA_HEADS = 8
MLA_NOPE = 64
MLA_ROPE = 32
MLA_V = 64
Q_LORA = 384
KV_LORA = 256
ROPE_THETA = 10000.0
MLA_QK = MLA_NOPE + MLA_ROPE
MLA_WIDTH = MLA_HEADS * MLA_V

DIL_HEADS = 8
DIL_HEAD_DIM = 64
DIL_PATTERNS = ((128, 1), (512, 4), (2048, 16))
DIL_WIDTH = DIL_HEADS * DIL_HEAD_DIM

BLOCK = 128
N_BRANCH = 2
D_FF = 4 * D_MODEL
LN_EPS = 1e-5
RMS_EPS = 1e-6
NEG = -1e30
ALPHA = (2 * DEPTH) ** 0.25
BETA = (8 * DEPTH) ** -0.25

SPLITS = (Q_LORA,
          Q_LORA + KV_LORA,
          Q_LORA + KV_LORA + MLA_ROPE,
          Q_LORA + KV_LORA + MLA_ROPE + 3 * DIL_WIDTH)
IN_WIDTH = Q_LORA + KV_LORA + MLA_ROPE + 3 * DIL_WIDTH + N_BRANCH * D_MODEL

kernel_name = 'hybrid_mla_dilated_gated_deepnorm'


def layer_norm(x, g, b):
    xf = x.astype(jnp.float32)
    mu = jnp.mean(xf, axis=-1, keepdims=True)
    var = jnp.mean(jnp.square(xf - mu), axis=-1, keepdims=True)
    y = (xf - mu) * lax.rsqrt(var + LN_EPS) * g.astype(jnp.float32) + b.astype(jnp.float32)
    return y.astype(x.dtype)


def rms_norm(x, g):
    xf = x.astype(jnp.float32)
    y = xf * lax.rsqrt(jnp.mean(jnp.square(xf), axis=-1, keepdims=True) + RMS_EPS)
    return (y * g.astype(jnp.float32)).astype(x.dtype)


def apply_rope(t, pos):
    half = t.shape[-1] // 2
    inv = jnp.power(ROPE_THETA, -jnp.arange(half, dtype=jnp.float32) / half)
    ang = pos.astype(jnp.float32)[:, None] * inv[None, :]
    cos = jnp.cos(ang)[None, :, None, :]
    sin = jnp.sin(ang)[None, :, None, :]
    tf = t.astype(jnp.float32)
    t1, t2 = tf[..., :half], tf[..., half:]
    return jnp.concatenate([t1 * cos - t2 * sin, t1 * sin + t2 * cos], axis=-1).astype(t.dtype)


def alibi_slopes(n):
    return jnp.asarray([2.0 ** (-8.0 * (i + 1) / n) for i in range(n)], dtype=jnp.float32)


def mla_attention(q_a, kv_a, k_r, g_q_a, w_uq, g_kv_a, w_ukv):
    B, S, _ = q_a.shape
    pos = jnp.arange(S)
    q = (rms_norm(q_a, g_q_a) @ w_uq).reshape(B, S, MLA_HEADS, MLA_QK)
    q = jnp.concatenate([q[..., :MLA_NOPE], apply_rope(q[..., MLA_NOPE:], pos)], axis=-1)
    kv = (rms_norm(kv_a, g_kv_a) @ w_ukv).reshape(B, S, MLA_HEADS, MLA_NOPE + MLA_V)
    k_rope = apply_rope(k_r[:, :, None, :], pos)
    k = jnp.concatenate([kv[..., :MLA_NOPE],
                         jnp.broadcast_to(k_rope, (B, S, MLA_HEADS, MLA_ROPE))], axis=-1)
    v = kv[..., MLA_NOPE:]
    scale = MLA_QK ** -0.5
    nb = S // BLOCK
    q_blocks = q.reshape(B, nb, BLOCK, MLA_HEADS, MLA_QK).transpose(1, 0, 2, 3, 4)
    kpos = jnp.arange(S)

    def one_block(args):
        qb, i = args
        s = jnp.einsum('bqhd,bkhd->bhqk', qb, k).astype(jnp.float32) * scale
        qpos = i * BLOCK + jnp.arange(BLOCK)
        s = jnp.where((kpos[None, :] <= qpos[:, None])[None, None], s, NEG)
        p = jax.nn.softmax(s, axis=-1).astype(v.dtype)
        return jnp.einsum('bhqk,bkhd->bqhd', p, v)

    o = lax.map(one_block, (q_blocks, jnp.arange(nb)))
    return o.transpose(1, 0, 2, 3, 4).reshape(B, S, MLA_WIDTH)


def dilated_pattern(q, k, v, window, dilation, slopes):
    B, S, H, Dh = q.shape
    L = S // dilation
    J = window // dilation
    C = min(BLOCK, L)
    nb = -(-L // C)
    Lp = nb * C

    def to_classes(t):
        t = t.reshape(B, L, dilation, H, Dh).transpose(0, 2, 1, 3, 4)
        t = jnp.pad(t, ((0, 0), (0, 0), (0, Lp - L), (0, 0), (0, 0)))
        return t.reshape(B, dilation, nb, C, H, Dh)

    def with_prev(t):
        prev = jnp.pad(t, ((0, 0), (0, 0), (1, 0), (0, 0), (0, 0), (0, 0)))[:, :, :-1]
        return jnp.concatenate([prev, t], axis=3)

    def from_classes(t):
        X = t.shape[-1]
        t = t.reshape(B, dilation, Lp, H, X)[:, :, :L]
        return t.transpose(0, 2, 1, 3, 4).reshape(B, S, H, X)

    qc = to_classes(q)
    kc = with_prev(to_classes(k))
    vc = with_prev(to_classes(v))
    s = jnp.einsum('brnqhd,brnkhd->brnhqk', qc, kc).astype(jnp.float32) * (Dh ** -0.5)
    qi = jnp.arange(C)[:, None] + C
    ki = jnp.arange(2 * C)[None, :]
    dist = qi - ki
    valid = (dist >= 0) & (dist <= J)
    key_exists = (jnp.arange(nb)[:, None] > 0) | (jnp.arange(2 * C)[None, :] >= C)
    mask = valid[None] & key_exists[:, None, :]
    bias = -slopes[:, None, None] * (dilation * dist).astype(jnp.float32)[None]
    s = jnp.where(mask[None, None, :, None], s + bias, NEG)
    m = jnp.max(s, axis=-1)
    p = jnp.exp(s - m[..., None])
    den = jnp.sum(p, axis=-1)
    o = jnp.einsum('brnhqk,brnkhd->brnqhd', p, vc.astype(jnp.float32))
    den_t = den.transpose(0, 1, 2, 4, 3)[..., None]
    m_t = m.transpose(0, 1, 2, 4, 3)[..., None]
    return from_classes(o / den_t), from_classes(m_t), from_classes(den_t)


def dilated_attention(q, k, v):
    slopes = alibi_slopes(DIL_HEADS)
    res = [dilated_pattern(q, k, v, w, d, slopes) for (w, d) in DIL_PATTERNS]
    m_all = res[0][1]
    for r in res[1:]:
        m_all = jnp.maximum(m_all, r[1])
    num = 0.0
    tot = 0.0
    for o, m, den in res:
        wgt = den * jnp.exp(m - m_all)
        num = num + wgt * o
        tot = tot + wgt
    return (num / tot).astype(q.dtype)


def hybrid_layer(x, w_in, b_gate, g_q_a, w_uq, g_kv_a, w_ukv, w_o_mla, w_o_dil,
                 w_out, ln1_g, ln1_b, w_ff1, w_ff2, ln2_g, ln2_b):
    B, S, D = x.shape
    proj = x @ w_in
    q_a, kv_a, k_r, qkv_d, gates = jnp.split(proj, SPLITS, axis=-1)
    y_a = mla_attention(q_a, kv_a, k_r, g_q_a, w_uq, g_kv_a, w_ukv) @ w_o_mla
    qkv_d = qkv_d.reshape(B, S, 3, DIL_HEADS, DIL_HEAD_DIM)
    o_b = dilated_attention(qkv_d[:, :, 0], qkv_d[:, :, 1], qkv_d[:, :, 2])
    y_b = o_b.reshape(B, S, DIL_WIDTH) @ w_o_dil
    g = jax.nn.sigmoid(gates.reshape(B, S, N_BRANCH, D) + b_gate)
    mixed = (g[:, :, 0] * y_a + g[:, :, 1] * y_b) @ w_out
    h = layer_norm(ALPHA * x + mixed, ln1_g, ln1_b)
    f = jnp.square(jax.nn.relu(h @ w_ff1)) @ w_ff2
    return layer_norm(ALPHA * h + f, ln2_g, ln2_b)


def setup_inputs(seed: int = 0) -> dict:
    key = jax.random.key(seed)
    ks = jax.random.split(key, 20)
    f32 = jnp.float32

    def nrm(k, shape, fan_in, scale=1.0):
        return jax.random.normal(k, shape, f32) * (fan_in ** -0.5) * scale

    def gain(k, shape):
        return 1.0 + 0.02 * jax.random.normal(k, shape, f32)

    def small(k, shape):
        return 0.02 * jax.random.normal(k, shape, f32)

    L_ = DEPTH
    return {
        'x': jax.random.normal(ks[0], (BATCH, SEQ, D_MODEL), f32),
        'w_in': nrm(ks[1], (L_, D_MODEL, IN_WIDTH), D_MODEL),
        'b_gate': small(ks[2], (L_, N_BRANCH, D_MODEL)),
        'g_q_a': gain(ks[3], (L_, Q_LORA)),
        'w_uq': nrm(ks[4], (L_, Q_LORA, MLA_HEADS * MLA_QK), Q_LORA),
        'g_kv_a': gain(ks[5], (L_, KV_LORA)),
        'w_ukv': nrm(ks[6], (L_, KV_LORA, MLA_HEADS * (MLA_NOPE + MLA_V)), KV_LORA),
        'w_o_mla': nrm(ks[7], (L_, MLA_WIDTH, D_MODEL), MLA_WIDTH, BETA),
        'w_o_dil': nrm(ks[8], (L_, DIL_WIDTH, D_MODEL), DIL_WIDTH, BETA),
        'w_out': nrm(ks[9], (L_, D_MODEL, D_MODEL), D_MODEL, BETA),
        'ln1_g': gain(ks[10], (L_, D_MODEL)),
        'ln1_b': small(ks[11], (L_, D_MODEL)),
        'w_ff1': nrm(ks[12], (L_, D_MODEL, D_FF), D_MODEL, BETA),
        'w_ff2': nrm(ks[13], (L_, D_FF, D_MODEL), D_FF, BETA),
        'ln2_g': gain(ks[14], (L_, D_MODEL)),
        'ln2_b': small(ks[15], (L_, D_MODEL)),
    }


def reference(x, w_in, b_gate, g_q_a, w_uq, g_kv_a, w_ukv, w_o_mla, w_o_dil,
              w_out, ln1_g, ln1_b, w_ff1, w_ff2, ln2_g, ln2_b):
    for l in range(DEPTH):
        x = hybrid_layer(x, w_in[l], b_gate[l], g_q_a[l], w_uq[l], g_kv_a[l], w_ukv[l],
                         w_o_mla[l], w_o_dil[l], w_out[l], ln1_g[l], ln1_b[l],
                         w_ff1[l], w_ff2[l], ln2_g[l], ln2_b[l])
    return x
```

```cpp
#include <hip/hip_runtime.h>
#include <hip/hip_cooperative_groups.h>
#include <cstdio>
#include <cstdint>
namespace cg = cooperative_groups;

#define LAS __attribute__((address_space(3)))
typedef unsigned short bf16_t;
typedef float f32x4 __attribute__((ext_vector_type(4)));
typedef unsigned u32x4 __attribute__((ext_vector_type(4)));
typedef unsigned u32x2 __attribute__((ext_vector_type(2)));

constexpr int BATCH = 16, SEQ = 2048, DM = 1024, M = BATCH * SEQ;
constexpr int NH = 8;
constexpr int QLORA = 384, KVLORA = 256, ROPE = 32, NOPE = 64, VD = 64, QK = 96;
constexpr int NIN = 4352;
constexpr int PSW = 768, QKVDW = 1536, GATEW = 2048;
constexpr int DFF = 4096;
constexpr float LN_EPS = 1e-5f, RMS_EPS = 1e-6f;
constexpr float ALPHA = 1.189207115002721f;
constexpr float LOG2E = 1.4426950408889634f;
constexpr float QSCALE = 0.10206207261596577f * LOG2E;

constexpr size_t MiB = 1u << 20;
constexpr size_t WS_WIN = 2 * MiB;
constexpr size_t WS_WUQ = 11 * MiB;
constexpr size_t WS_WUKV = 12 * MiB;
constexpr size_t WS_WOAB = 13 * MiB;
constexpr size_t WS_WOUT = 15 * MiB;
constexpr size_t WS_WFF1 = 17 * MiB;
constexpr size_t WS_WFF2 = 25 * MiB;
constexpr size_t WS_ROPE = 33 * MiB;
constexpr size_t WS_SUMSQ = 33 * MiB + 512 * 1024;
constexpr size_t WS_PS = 34 * MiB;
constexpr size_t WS_QKVD = 82 * MiB;
constexpr size_t WS_GATES = 178 * MiB;
constexpr size_t WS_XB = 306 * MiB;
constexpr size_t WS_KV = 370 * MiB;
constexpr size_t WS_OAB = 434 * MiB;
constexpr size_t WS_KR = 498 * MiB;
constexpr size_t WS_HID = 34 * MiB;
constexpr size_t WS_END = 500 * MiB;

__device__ __forceinline__ float bf2f(bf16_t v) { return __uint_as_float((unsigned)v << 16); }
__device__ __forceinline__ unsigned f2bf(float f) { unsigned u = __float_as_uint(f); return (u + 0x7fffu + ((u >> 16) & 1u)) >> 16; }
__device__ __forceinline__ unsigned pk2(float lo, float hi) { return f2bf(lo) | (f2bf(hi) << 16); }
__device__ __forceinline__ float lo16(unsigned u) { return __uint_as_float(u << 16); }
__device__ __forceinline__ float hi16(unsigned u) { return __uint_as_float(u & 0xffff0000u); }
__device__ __forceinline__ float wave_sum(float v) {
#pragma unroll
    for (int o = 1; o < 64; o <<= 1) v += __shfl_xor(v, o);
    return v;
}

struct Args { const float* in[16]; float* out; unsigned char* ws; int ph_lo, ph_hi; };

struct Ctx {
    int tid, lane, wave, gw, ngw; long gt, ngt;
    const float *x, *w_in, *b_gate, *g_q_a, *w_uq, *g_kv_a, *w_ukv, *w_o_mla, *w_o_dil, *w_out, *ln1_g, *ln1_b, *w_ff1, *w_ff2, *ln2_g, *ln2_b;
    float* out; unsigned char* ws;
    bf16_t *WIN, *WUQ, *WUKV, *WOAB, *WOUT, *WFF1, *WFF2, *PS, *QKVD, *GATES, *XB, *Q, *MIXIN, *KV, *T, *HB, *OAB, *KR, *HID;
    float* ROPET; float* SUMSQ;
};

__device__ __forceinline__ void transpose_item(const float* W, int Nsrc, int src_n0, const float* kscale, bf16_t* WT, int K, int dst_n0, int k0, LAS float* scr, int lane) {
#pragma unroll 8
    for (int i = 0; i < 32; ++i) {
        const int kk = 2 * i + (lane >> 5);
        float v = 0.f;
        if (src_n0 >= 0) { v = W[(size_t)(k0 + kk) * Nsrc + src_n0 + (lane & 31)]; if (kscale) v *= kscale[k0 + kk]; }
        scr[kk * 33 + (lane & 31)] = v;
    }
    asm volatile("s_waitcnt lgkmcnt(0)" ::: "memory");
    const int c = lane & 7;
#pragma unroll
    for (int j = 0; j < 4; ++j) {
        const int n = (lane >> 3) + 8 * j; const LAS float* s = scr + (8 * c) * 33 + n;
        u32x4 o; o.x = pk2(s[0 * 33], s[1 * 33]); o.y = pk2(s[2 * 33], s[3 * 33]); o.z = pk2(s[4 * 33], s[5 * 33]); o.w = pk2(s[6 * 33], s[7 * 33]);
        *(u32x4*)(WT + (size_t)(dst_n0 + n) * K + k0 + 8 * c) = o;
    }
    asm volatile("s_waitcnt lgkmcnt(0)" ::: "memory");
}
__device__ __forceinline__ bool tr_matrix(int& r, const float* W, int K, int Nsrc, int Ndst, bool in_map, const float* kscale, bf16_t* WT, int dst_row_off, LAS float* scr, int lane) {
    const int nblk = Ndst / 32, items = (K / 64) * nblk;
    if (r >= items) { r -= items; return false; }
    const int kb = r / nblk, nb = r % nblk, n0 = nb * 32;
    int src = n0;
    if (in_map) src = (n0 < 672) ? n0 : (n0 < 768 ? -1 : n0 - 96);
    transpose_item(W, Nsrc, src, kscale, WT, K, dst_row_off + n0, kb * 64, scr, lane);
    return true;
}
__device__ __forceinline__ void p0_prologue(Ctx& C, LAS unsigned char* lds) {
    LAS float* scr = (LAS float*)(lds + C.wave * 16384);
    constexpr int NITEMS = 16 * 136 + 6 * 24 + 4 * 32 + 8 * 32 + 8 * 32 + 16 * 32 + 16 * 128 + 64 * 32;
    for (int it = C.gw; it < NITEMS; it += C.ngw) {
        int r = it;
        if (tr_matrix(r, C.w_in, 1024, 4256, NIN, true, nullptr, C.WIN, 0, scr, C.lane)) continue;
        if (tr_matrix(r, C.w_uq, QLORA, 768, 768, false, C.g_q_a, C.WUQ, 0, scr, C.lane)) continue;
        if (tr_matrix(r, C.w_ukv, KVLORA, 1024, 1024, false, C.g_kv_a, C.WUKV, 0, scr, C.lane)) continue;
        if (tr_matrix(r, C.w_o_mla, 512, 1024, 1024, false, nullptr, C.WOAB, 0, scr, C.lane)) continue;
        if (tr_matrix(r, C.w_o_dil, 512, 1024, 1024, false, nullptr, C.WOAB, 1024, scr, C.lane)) continue;
        if (tr_matrix(r, C.w_out, 1024, 1024, 1024, false, nullptr, C.WOUT, 0, scr, C.lane)) continue;
        if (tr_matrix(r, C.w_ff1, 1024, 4096, 4096, false, nullptr, C.WFF1, 0, scr, C.lane)) continue;
        tr_matrix(r, C.w_ff2, 4096, 1024, 1024, false, nullptr, C.WFF2, 0, scr, C.lane);
    }
    {
        const f32x4* xs = (const f32x4*)C.x; u32x2* xd = (u32x2*)C.XB; const long n4 = (long)M * DM / 4;
        for (long i = C.gt; i < n4; i += C.ngt) { const f32x4 v = xs[i]; u32x2 o; o.x = pk2(v.x, v.y); o.y = pk2(v.z, v.w); xd[i] = o; }
    }
    for (long i = C.gt; i < SEQ * 16; i += C.ngt) {
        const int pos = (int)(i >> 4), j = (int)(i & 15);
        const float inv = powf(10000.0f, -(float)j / 16.0f); const float ang = (float)pos * inv;
        C.ROPET[2 * i] = cosf(ang); C.ROPET[2 * i + 1] = sinf(ang);
    }
    for (long i = C.gt; i < (long)M * 2; i += C.ngt) C.SUMSQ[i] = 0.f;
}

template <class F> __device__ __forceinline__ void naive_gemm(Ctx& C, const bf16_t* A, int lda, const bf16_t* Bt, int ldb, int Mr, int N, int K, F epi) {
    const int n4 = N / 4; const long total = (long)Mr * n4;
    for (long idx = C.gt; idx < total; idx += C.ngt) {
        const int m = (int)(idx / n4), n0 = (int)(idx % n4) * 4;
        float a0 = 0.f, a1 = 0.f, a2 = 0.f, a3 = 0.f, ss = 0.f;
        const bf16_t* ar = A + (size_t)m * lda; const bf16_t* br = Bt + (size_t)n0 * ldb;
        for (int k = 0; k < K; k += 8) {
            const u32x4 av = *(const u32x4*)(ar + k);
            const u32x4 b0 = *(const u32x4*)(br + k), b1 = *(const u32x4*)(br + ldb + k), b2 = *(const u32x4*)(br + 2 * ldb + k), b3 = *(const u32x4*)(br + 3 * ldb + k);
#pragma unroll
            for (int e = 0; e < 4; ++e) {
                const float al = lo16(av[e]), ah = hi16(av[e]);
                ss += al * al + ah * ah;
                a0 += al * lo16(b0[e]) + ah * hi16(b0[e]); a1 += al * lo16(b1[e]) + ah * hi16(b1[e]);
                a2 += al * lo16(b2[e]) + ah * hi16(b2[e]); a3 += al * lo16(b3[e]) + ah * hi16(b3[e]);
            }
        }
        epi(m, n0, a0, a1, a2, a3, ss);
    }
}
__device__ __forceinline__ float sigmoidf_(float v) { return 1.0f / (1.0f + __expf(-v)); }

__device__ __forceinline__ void p1_naive(Ctx& C) {
    naive_gemm(C, C.XB, DM, C.WIN, DM, M, NIN, DM, [&](int m, int n0, float a0, float a1, float a2, float a3, float) {
        u32x2 o;
        if (n0 < PSW) { o.x = pk2(a0, a1); o.y = pk2(a2, a3); *(u32x2*)(C.PS + (size_t)m * PSW + n0) = o; }
        else if (n0 < PSW + QKVDW) { o.x = pk2(a0, a1); o.y = pk2(a2, a3); *(u32x2*)(C.QKVD + (size_t)m * QKVDW + (n0 - PSW)) = o; }
        else { const int g = n0 - PSW - QKVDW; const f32x4 b = *(const f32x4*)(C.b_gate + g);
            o.x = pk2(sigmoidf_(a0 + b.x), sigmoidf_(a1 + b.y)); o.y = pk2(sigmoidf_(a2 + b.z), sigmoidf_(a3 + b.w)); *(u32x2*)(C.GATES + (size_t)m * GATEW + g) = o; }
    });
}
__device__ __forceinline__ void p2_naive(Ctx& C) {
    naive_gemm(C, C.PS, PSW, C.WUQ, QLORA, M, 768, QLORA, [&](int m, int n0, float a0, float a1, float a2, float a3, float ss) {
        const float rs = rsqrtf(ss * (1.0f / QLORA) + RMS_EPS) * QSCALE;
        u32x2 o; o.x = pk2(a0 * rs, a1 * rs); o.y = pk2(a2 * rs, a3 * rs); *(u32x2*)(C.Q + (size_t)m * 768 + n0) = o;
    });
    naive_gemm(C, C.PS + QLORA, PSW, C.WUKV, KVLORA, M, 1024, KVLORA, [&](int m, int n0, float a0, float a1, float a2, float a3, float ss) {
        const float rs = rsqrtf(ss * (1.0f / KVLORA) + RMS_EPS);
        u32x2 o; o.x = pk2(a0 * rs, a1 * rs); o.y = pk2(a2 * rs, a3 * rs); *(u32x2*)(C.KV + (size_t)m * 1024 + n0) = o;
    });
    for (long idx = C.gt; idx < (long)M * 16; idx += C.ngt) {
        const int m = (int)(idx >> 4), j = (int)(idx & 15), pos = m % SEQ;
        const float c = C.ROPET[2 * (pos * 16 + j)], s = C.ROPET[2 * (pos * 16 + j) + 1];
        const float t1 = bf2f(C.PS[(size_t)m * PSW + 640 + j]), t2 = bf2f(C.PS[(size_t)m * PSW + 656 + j]);
        C.KR[(size_t)m * 32 + j] = (bf16_t)f2bf(t1 * c - t2 * s); C.KR[(size_t)m * 32 + 16 + j] = (bf16_t)f2bf(t1 * s + t2 * c);
    }
}
__device__ __forceinline__ void p2b_naive_qrope(Ctx& C) {
    for (long idx = C.gt; idx < (long)M * NH * 16; idx += C.ngt) {
        const int j = (int)(idx & 15), h = (int)((idx >> 4) & 7), m = (int)(idx >> 7), pos = m % SEQ;
        const float c = C.ROPET[2 * (pos * 16 + j)], s = C.ROPET[2 * (pos * 16 + j) + 1];
        bf16_t* p = C.Q + (size_t)m * 768 + h * 96 + 64 + j;
        const float t1 = bf2f(p[0]), t2 = bf2f(p[16]);
        p[0] = (bf16_t)f2bf(t1 * c - t2 * s); p[16] = (bf16_t)f2bf(t1 * s + t2 * c);
    }
}

__device__ __forceinline__ void p3_naive_mla(Ctx& C) {
    for (long idx = C.gt; idx < (long)BATCH * NH * SEQ; idx += C.ngt) {
        const int q = (int)(idx % SEQ), h = (int)((idx / SEQ) % NH), b = (int)(idx / (SEQ * NH));
        const size_t m = (size_t)b * SEQ + q;
        u32x4 qv[12];
#pragma unroll
        for (int i = 0; i < 12; ++i) qv[i] = *(const u32x4*)(C.Q + m * 768 + h * 96 + i * 8);
        float o[64];
#pragma unroll
        for (int d = 0; d < 64; ++d) o[d] = 0.f;
        float mx = -1e30f, l = 0.f;
        const int kmax = __builtin_amdgcn_readfirstlane(q | 63);
        for (int k = 0; k <= kmax; ++k) {
            const size_t mk = (size_t)b * SEQ + k;
            const bf16_t* kp = C.KV + mk * 1024 + h * 128; const bf16_t* rp = C.KR + mk * 32;
            float s = 0.f;
#pragma unroll
            for (int i = 0; i < 8; ++i) { const u32x4 kv = *(const u32x4*)(kp + i * 8);
#pragma unroll
                for (int e = 0; e < 4; ++e) s += lo16(qv[i][e]) * lo16(kv[e]) + hi16(qv[i][e]) * hi16(kv[e]); }
#pragma unroll
            for (int i = 0; i < 4; ++i) { const u32x4 kv = *(const u32x4*)(rp + i * 8);
#pragma unroll
                for (int e = 0; e < 4; ++e) s += lo16(qv[8 + i][e]) * lo16(kv[e]) + hi16(qv[8 + i][e]) * hi16(kv[e]); }
            if (k <= q) {
                const float mn = fmaxf(mx, s), f = exp2f(mx - mn), p = exp2f(s - mn);
                l = l * f + p; mx = mn;
#pragma unroll
                for (int i = 0; i < 8; ++i) { const u32x4 vv = *(const u32x4*)(kp + 64 + i * 8);
#pragma unroll
                    for (int e = 0; e < 4; ++e) { o[i * 8 + 2 * e] = o[i * 8 + 2 * e] * f + p * lo16(vv[e]); o[i * 8 + 2 * e + 1] = o[i * 8 + 2 * e + 1] * f + p * hi16(vv[e]); } }
            }
        }
        const float il = 1.0f / l;
        bf16_t* op = C.OAB + m * 512 + h * 64;
#pragma unroll
        for (int i = 0; i < 8; ++i) { u32x4 w; w.x = pk2(o[i * 8] * il, o[i * 8 + 1] * il); w.y = pk2(o[i * 8 + 2] * il, o[i * 8 + 3] * il); w.z = pk2(o[i * 8 + 4] * il, o[i * 8 + 5] * il); w.w = pk2(o[i * 8 + 6] * il, o[i * 8 + 7] * il); *(u32x4*)(op + i * 8) = w; }
    }
}
__device__ __forceinline__ void p3_naive_dil(Ctx& C) {
    for (long idx = C.gt; idx < (long)BATCH * NH * SEQ; idx += C.ngt) {
        const int t = (int)(idx % SEQ), h = (int)((idx / SEQ) % NH), b = (int)(idx / (SEQ * NH));
        const size_t m = (size_t)b * SEQ + t;
        const float slope = exp2f(-(float)(h + 1));
        u32x4 qv[8];
#pragma unroll
        for (int i = 0; i < 8; ++i) qv[i] = *(const u32x4*)(C.QKVD + m * QKVDW + h * 64 + i * 8);
        float num[64];
#pragma unroll
        for (int d = 0; d < 64; ++d) num[d] = 0.f;
        float m_all = -1e30f, tot = 0.f;
        for (int p = 0; p < 3; ++p) {
            const int dil = (p == 0) ? 1 : (p == 1 ? 4 : 16);
            float o[64];
#pragma unroll
            for (int d = 0; d < 64; ++d) o[d] = 0.f;
            float mx = -1e30f, l = 0.f;
            for (int j = 0; j <= 128; ++j) {
                const int tk = t - j * dil; if (tk < 0) break;
                const bf16_t* kp = C.QKVD + ((size_t)b * SEQ + tk) * QKVDW + 512 + h * 64;
                float s = 0.f;
#pragma unroll
                for (int i = 0; i < 8; ++i) { const u32x4 kv = *(const u32x4*)(kp + i * 8);
#pragma unroll
                    for (int e = 0; e < 4; ++e) s += lo16(qv[i][e]) * lo16(kv[e]) + hi16(qv[i][e]) * hi16(kv[e]); }
                s = s * 0.125f - slope * (float)(dil * j);
                const float mn = fmaxf(mx, s), f = __expf(mx - mn), pe = __expf(s - mn);
                l = l * f + pe; mx = mn;
#pragma unroll
                for (int i = 0; i < 8; ++i) { const u32x4 vv = *(const u32x4*)(kp + 512 + i * 8);
#pragma unroll
                    for (int e = 0; e < 4; ++e) { o[i * 8 + 2 * e] = o[i * 8 + 2 * e] * f + pe * lo16(vv[e]); o[i * 8 + 2 * e + 1] = o[i * 8 + 2 * e + 1] * f + pe * hi16(vv[e]); } }
            }
            const float mn = fmaxf(m_all, mx), fa = __expf(m_all - mn), fb = __expf(mx - mn);
            tot = tot * fa + l * fb; m_all = mn;
#pragma unroll
            for (int d = 0; d < 64; ++d) num[d] = num[d] * fa + o[d] * fb;
        }
        const float it = 1.0f / tot;
        bf16_t* op = C.OAB + ((size_t)M + m) * 512 + h * 64;
#pragma unroll
        for (int i = 0; i < 8; ++i) { u32x4 w; w.x = pk2(num[i * 8] * it, num[i * 8 + 1] * it); w.y = pk2(num[i * 8 + 2] * it, num[i * 8 + 3] * it); w.z = pk2(num[i * 8 + 4] * it, num[i * 8 + 5] * it); w.w = pk2(num[i * 8 + 6] * it, num[i * 8 + 7] * it); *(u32x4*)(op + i * 8) = w; }
    }
}
__device__ __forceinline__ void p4_naive(Ctx& C) {
    naive_gemm(C, C.OAB, 512, C.WOAB, 512, M, 1024, 512, [&](int m, int n0, float a0, float a1, float a2, float a3, float) {
        const u32x2 g = *(const u32x2*)(C.GATES + (size_t)m * GATEW + n0);
        u32x2 o; o.x = pk2(a0 * lo16(g.x), a1 * hi16(g.x)); o.y = pk2(a2 * lo16(g.y), a3 * hi16(g.y)); *(u32x2*)(C.T + (size_t)m * 1024 + n0) = o;
    });
}
__device__ __forceinline__ void p4b_naive(Ctx& C) {
    naive_gemm(C, C.OAB + (size_t)M * 512, 512, C.WOAB + (size_t)1024 * 512, 512, M, 1024, 512, [&](int m, int n0, float a0, float a1, float a2, float a3, float) {
        const u32x2 g = *(const u32x2*)(C.GATES + (size_t)m * GATEW + 1024 + n0); const u32x2 t = *(const u32x2*)(C.T + (size_t)m * 1024 + n0);
        u32x2 o; o.x = pk2(lo16(t.x) + a0 * lo16(g.x), hi16(t.x) + a1 * hi16(g.x)); o.y = pk2(lo16(t.y) + a2 * lo16(g.y), hi16(t.y) + a3 * hi16(g.y)); *(u32x2*)(C.MIXIN + (size_t)m * 1024 + n0) = o;
    });
}
__device__ __forceinline__ void p5_naive(Ctx& C) {
    naive_gemm(C, C.MIXIN, 1024, C.WOUT, 1024, M, 1024, 1024, [&](int m, int n0, float a0, float a1, float a2, float a3, float) {
        const f32x4 xv = *(const f32x4*)(C.x + (size_t)m * DM + n0);
        *(f32x4*)(C.out + (size_t)m * DM + n0) = (f32x4){ALPHA * xv.x + a0, ALPHA * xv.y + a1, ALPHA * xv.z + a2, ALPHA * xv.w + a3};
    });
}
__device__ __forceinline__ void ln_rows(Ctx& C, const float* g, const float* bta, bf16_t* hb) {
    for (int m = C.gw; m < M; m += C.ngw) {
        f32x4* xr = (f32x4*)(C.out + (size_t)m * DM) + C.lane;
        f32x4 v[4]; float s = 0.f;
#pragma unroll
        for (int j = 0; j < 4; ++j) { v[j] = xr[64 * j]; s += (v[j].x + v[j].y) + (v[j].z + v[j].w); }
        const float mean = wave_sum(s) * (1.f / DM); float s2 = 0.f;
#pragma unroll
        for (int j = 0; j < 4; ++j) { v[j] = v[j] - mean; s2 += (v[j].x * v[j].x + v[j].y * v[j].y) + (v[j].z * v[j].z + v[j].w * v[j].w); }
        const float rstd = rsqrtf(wave_sum(s2) * (1.f / DM) + LN_EPS);
#pragma unroll
        for (int j = 0; j < 4; ++j) {
            const f32x4 gg = ((const f32x4*)g)[C.lane + 64 * j], bb = ((const f32x4*)bta)[C.lane + 64 * j];
            const f32x4 o = v[j] * rstd * gg + bb; xr[64 * j] = o;
            if (hb) { u32x2 w; w.x = pk2(o.x, o.y); w.y = pk2(o.z, o.w); ((u32x2*)(hb + (size_t)m * DM))[C.lane + 64 * j] = w; }
        }
    }
}
__device__ __forceinline__ void p7_naive(Ctx& C) {
    naive_gemm(C, C.HB, DM, C.WFF1, DM, M, DFF, DM, [&](int m, int n0, float a0, float a1, float a2, float a3, float) {
        a0 = fmaxf(a0, 0.f); a1 = fmaxf(a1, 0.f); a2 = fmaxf(a2, 0.f); a3 = fmaxf(a3, 0.f);
        u32x2 o; o.x = pk2(a0 * a0, a1 * a1); o.y = pk2(a2 * a2, a3 * a3); *(u32x2*)(C.HID + (size_t)m * DFF + n0) = o;
    });
}
__device__ __forceinline__ void p8_naive(Ctx& C) {
    naive_gemm(C, C.HID, DFF, C.WFF2, DFF, M, DM, DFF, [&](int m, int n0, float a0, float a1, float a2, float a3, float) {
        f32x4* p = (f32x4*)(C.out + (size_t)m * DM + n0); const f32x4 hv = *p;
        *p = (f32x4){ALPHA * hv.x + a0, ALPHA * hv.y + a1, ALPHA * hv.z + a2, ALPHA * hv.w + a3};
    });
}

namespace pg8 {
typedef short bf16x8 __attribute__((ext_vector_type(8)));
constexpr int BM = 256, BK = 64, HALF = 128, HTB = HALF * BK * 2, STAGE_BYTES = 8 * HTB, NXCD = 8, WGM = 8;
__host__ __device__ __forceinline__ int lds_byte(int r, int c) { const int st = (r >> 4) * 2 + (c >> 5), rr = r & 15, cc = c & 31, ob = rr * 64 + cc * 2; return st * 1024 + (ob ^ (((ob >> 9) & 1) << 5)); }
__host__ __device__ __forceinline__ void stage_rc(int b, int& R, int& C) { const int st = b / 1024, sb = b % 1024, swz = sb ^ (((sb >> 9) & 1) << 5); R = (st >> 1) * 16 + swz / 64; C = (st & 1) * 32 + (swz % 64) / 2; }
__host__ __device__ __forceinline__ int perm32(int rho) { const int n = rho >> 4, i = rho & 15; return 8 * (i >> 2) + 4 * n + (i & 3); }
struct Unit { int pm, pn; };
struct Gemm { const bf16_t* A; const bf16_t* Bt; int K, lda, ldb; };
__device__ __forceinline__ void swz_tile(int L, int nM, int nN, Unit& u) {
    const int nwg = nM * nN; int wgid = L;
    { const int q = nwg / NXCD, r = nwg % NXCD, xcd = wgid % NXCD, off = wgid / NXCD; wgid = (xcd < r ? xcd * (q + 1) : r * (q + 1) + (xcd - r) * q) + off; }
    const int nig = WGM * nN, gid = wgid / nig, fm = gid * WGM, gsz = (nM - fm) < WGM ? (nM - fm) : WGM;
    u.pm = fm + ((wgid % nig) % gsz); u.pn = (wgid % nig) / gsz;
}
struct StaticOrder {
    int nM, nN, nwg, G, c;
    __device__ void init(int Mr, int N, int G_, int c_) { nM = Mr / BM; nN = N / BM; nwg = nM * nN; G = G_; c = c_; }
    __device__ bool next(int i, Unit& u) const { const long L = (long)i * G + c; if (L >= nwg) return false; swz_tile((int)L, nM, nN, u); return true; }
};
struct PairOrder {
    int nM, nN, nwg, G, c;
    __device__ void init(int Mr, int N, int G_, int c_) { nM = Mr / BM; nN = N / BM; nwg = nM * nN; G = G_; c = c_; }
    __device__ bool next(int i, Unit& u) const { const long L = (long)(i >> 1) * G + c; if (L >= nwg) return false; swz_tile((int)L, nM, nN, u); if (i & 1) { u.pm += nM; u.pn += nN; } return true; }
};
__device__ __forceinline__ unsigned cvt_pk_bf16(float lo, float hi) { unsigned r; asm volatile("v_cvt_pk_bf16_f32 %0, %1, %2" : "=v"(r) : "v"(lo), "v"(hi)); return r; }

template <class Epi, class Sched, bool ALIGN_EPI>
__device__ __forceinline__ void gemm_phase(LAS unsigned char* lds, const Gemm g, const Sched& S, const Epi& E) {
    const int tid = threadIdx.x, wid = __builtin_amdgcn_readfirstlane(tid >> 6), lane = tid & 63, wr = wid >> 2, wc = wid & 3, fr = lane & 15, fq = lane >> 4;
    const int K = g.K, nt = K / BK;
    unsigned voffA[2], voffB[2];
#pragma unroll
    for (int i = 0; i < 2; ++i) { int R, C; stage_rc(tid * 16 + i * 8192, R, C); const int Rb = Epi::PERM ? ((R & ~31) + perm32(R & 31)) : R;
        voffA[i] = (unsigned)(R * g.lda + C) * 2u; voffB[i] = (unsigned)(Rb * g.ldb + C) * 2u; }
    const size_t kstep = (size_t)(BK * 2);
    const size_t hstepA = (size_t)HALF * g.lda * 2, hstepB = (size_t)HALF * g.ldb * 2;
    const size_t tstepA = 2 * hstepA, tstepB = 2 * hstepB;
    const unsigned ldsw = (unsigned)wid * 1024u;
    const int aoff = lds_byte(wr * 64 + fr, fq * 8), boff = lds_byte(wc * 32 + fr, fq * 8);
#define PG8_SA(b, h) (((b) * 2 + (h)) * HTB)
#define PG8_SB(b, h) ((4 + (b) * 2 + (h)) * HTB)
#define PG8_STAGE(bufoff, gbase, voff) do { _Pragma("unroll") for (int _i = 0; _i < 2; ++_i) \
        __builtin_amdgcn_global_load_lds((const unsigned*)((const char*)(gbase) + (voff)[_i]), (LAS unsigned*)(lds + (bufoff) + ldsw + _i * 8192), 16, 0, 0); } while (0)
#define PG8_LDA(dst, b, h) do { _Pragma("unroll") for (int m = 0; m < 4; ++m) _Pragma("unroll") for (int k = 0; k < 2; ++k) dst[m][k] = *(const LAS bf16x8*)(lds + PG8_SA(b, h) + aoff + m * 2048 + k * 1024); } while (0)
#define PG8_LDB(dst, b, h) do { _Pragma("unroll") for (int n = 0; n < 2; ++n) _Pragma("unroll") for (int k = 0; k < 2; ++k) dst[n][k] = *(const LAS bf16x8*)(lds + PG8_SB(b, h) + boff + n * 2048 + k * 1024); } while (0)
#define PG8_MMA(ai, bj, At, Bt) do { __builtin_amdgcn_s_setprio(1); _Pragma("unroll") for (int m = 0; m < 4; ++m) _Pragma("unroll") for (int n = 0; n < 2; ++n) _Pragma("unroll") for (int k = 0; k < 2; ++k) \
        acc[ai][bj][m][n] = __builtin_amdgcn_mfma_f32_16x16x32_bf16(Bt[n][k], At[m][k], acc[ai][bj][m][n], 0, 0, 0); __builtin_amdgcn_s_setprio(0); } while (0)
#define PG8_WAIT_V(n) asm volatile("s_waitcnt vmcnt(" #n ")" ::: "memory")
#define PG8_WAIT_L(n) asm volatile("s_waitcnt lgkmcnt(" #n ")" ::: "memory")
#define PG8_BAR __builtin_amdgcn_s_barrier()
#define PG8_SCHED __builtin_amdgcn_sched_barrier(0)
    Unit cur, nxt; int ui = 0;
    if (!S.next(0, cur)) return;
    f32x4 acc[2][2][4][2];
#pragma unroll
    for (int a = 0; a < 2; ++a)
#pragma unroll
        for (int b = 0; b < 2; ++b)
#pragma unroll
            for (int m = 0; m < 4; ++m)
#pragma unroll
                for (int n = 0; n < 2; ++n) acc[a][b][m][n] = (f32x4){0.f, 0.f, 0.f, 0.f};
    bf16x8 At[4][2], B0[2][2], B1[2][2];
    const char* cA = (const char*)g.A + (size_t)cur.pm * tstepA; const char* cB = (const char*)g.Bt + (size_t)cur.pn * tstepB;
    PG8_STAGE(PG8_SB(0, 0), cB, voffB); PG8_STAGE(PG8_SB(0, 1), cB + hstepB, voffB); PG8_STAGE(PG8_SA(0, 0), cA, voffA); PG8_STAGE(PG8_SA(0, 1), cA + hstepA, voffA);
    if (wr == 1) PG8_BAR;
    PG8_WAIT_V(2); PG8_BAR;
    PG8_STAGE(PG8_SB(1, 0), cB + kstep, voffB); PG8_STAGE(PG8_SA(1, 0), cA + kstep, voffA); PG8_STAGE(PG8_SB(1, 1), cB + hstepB + kstep, voffB);
    PG8_WAIT_V(6); PG8_BAR;
    for (;;) {
        const bool has_next = S.next(ui + 1, nxt);
        const char* nA = has_next ? (const char*)g.A + (size_t)nxt.pm * tstepA : cA; const char* nB = has_next ? (const char*)g.Bt + (size_t)nxt.pn * tstepB : cB;
#pragma nounroll
        for (int t = 0; t < nt; t += 2) {
            const bool last = (t == nt - 2);
            const char* a1 = cA + (size_t)(t + 1) * kstep;
            const char* a2 = last ? nA : cA + (size_t)(t + 2) * kstep; const char* b2 = last ? nB : cB + (size_t)(t + 2) * kstep;
            const char* a3 = a2 + kstep; const char* b3 = b2 + kstep;
            PG8_LDB(B0, 0, 0); PG8_LDB(B1, 0, 1); PG8_SCHED; PG8_LDA(At, 0, 0); PG8_STAGE(PG8_SA(1, 1), a1 + hstepA, voffA);
            PG8_WAIT_V(8); PG8_WAIT_L(0); PG8_BAR; PG8_MMA(0, 0, At, B0); PG8_MMA(0, 1, At, B1); PG8_BAR; PG8_SCHED;
            PG8_LDA(At, 0, 1); PG8_STAGE(PG8_SB(0, 0), b2, voffB); PG8_STAGE(PG8_SB(0, 1), b2 + hstepB, voffB); PG8_STAGE(PG8_SA(0, 0), a2, voffA);
            PG8_WAIT_V(8); PG8_WAIT_L(0); PG8_BAR; PG8_MMA(1, 0, At, B0); PG8_MMA(1, 1, At, B1); PG8_BAR; PG8_SCHED;
            PG8_LDB(B0, 1, 0); PG8_LDB(B1, 1, 1); PG8_SCHED; PG8_LDA(At, 1, 0); PG8_STAGE(PG8_SA(0, 1), a2 + hstepA, voffA);
            PG8_WAIT_V(8); PG8_WAIT_L(0); PG8_BAR; PG8_MMA(0, 0, At, B0); PG8_MMA(0, 1, At, B1); PG8_BAR; PG8_SCHED;
            PG8_LDA(At, 1, 1); PG8_STAGE(PG8_SB(1, 0), b3, voffB); PG8_STAGE(PG8_SB(1, 1), b3 + hstepB, voffB); PG8_STAGE(PG8_SA(1, 0), a3, voffA);
            PG8_WAIT_V(8); PG8_WAIT_L(0); PG8_BAR; PG8_MMA(1, 0, At, B0); PG8_MMA(1, 1, At, B1); PG8_BAR; PG8_SCHED;
        }
        if constexpr (ALIGN_EPI) { if (wr == 0) PG8_BAR; }
        E(acc, cur, wr, wc, fr, fq);
        if (!has_next) break;
#pragma unroll
        for (int a = 0; a < 2; ++a)
#pragma unroll
            for (int b = 0; b < 2; ++b)
#pragma unroll
                for (int m = 0; m < 4; ++m)
#pragma unroll
                    for (int n = 0; n < 2; ++n) acc[a][b][m][n] = (f32x4){0.f, 0.f, 0.f, 0.f};
        cur = nxt; cA = nA; cB = nB; ++ui;
        if constexpr (ALIGN_EPI) { if (wr == 1) PG8_BAR; }
    }
    PG8_WAIT_V(0);
    if constexpr (!ALIGN_EPI) { if (wr == 0) PG8_BAR; }
    PG8_BAR;
#undef PG8_SA
#undef PG8_SB
#undef PG8_STAGE
#undef PG8_LDA
#undef PG8_LDB
#undef PG8_MMA
#undef PG8_WAIT_V
#undef PG8_WAIT_L
#undef PG8_BAR
#undef PG8_SCHED
}

typedef f32x4 AccT[2][2][4][2];
__device__ __forceinline__ float sigm(float v) { return __builtin_amdgcn_rcpf(1.0f + __builtin_amdgcn_exp2f(-LOG2E * v)); }
__device__ __forceinline__ u32x4 pack8(const f32x4 v0, const f32x4 v1) { u32x4 w; w.x = cvt_pk_bf16(v0[0], v0[1]); w.y = cvt_pk_bf16(v0[2], v0[3]); w.z = cvt_pk_bf16(v1[0], v1[1]); w.w = cvt_pk_bf16(v1[2], v1[3]); return w; }

struct EpiIn {
    static constexpr bool PERM = true;
    bf16_t *PS, *QKVD, *GATES; const float* b_gate; float* SUMSQ;
    __device__ __forceinline__ void operator()(const AccT& acc, const Unit& u, int wr, int wc, int fr, int fq) const {
        const int row0 = u.pm * BM + wr * 64 + fr;
        int kind, ldc, colt; bf16_t* base;
        if (u.pn < 3) { kind = 0; base = PS; ldc = PSW; colt = u.pn * BM; } else if (u.pn < 9) { kind = 1; base = QKVD; ldc = QKVDW; colt = (u.pn - 3) * BM; } else { kind = 2; base = GATES; ldc = GATEW; colt = (u.pn - 9) * BM; }
        const int col0 = colt + wc * 32 + 8 * fq;
        f32x4 bv[2][2];
#pragma unroll
        for (int bj = 0; bj < 2; ++bj)
#pragma unroll
            for (int n = 0; n < 2; ++n) bv[bj][n] = (kind == 2) ? *(const f32x4*)(b_gate + col0 + bj * HALF + 4 * n) : (f32x4){0.f, 0.f, 0.f, 0.f};
#pragma unroll
        for (int ai = 0; ai < 2; ++ai)
#pragma unroll
            for (int m = 0; m < 4; ++m) { const int row = row0 + ai * HALF + m * 16; bf16_t* rowp = base + (size_t)row * ldc + col0;
#pragma unroll
                for (int bj = 0; bj < 2; ++bj) { f32x4 v0 = acc[ai][bj][m][0], v1 = acc[ai][bj][m][1];
                    if (kind == 2) { v0 += bv[bj][0]; v1 += bv[bj][1];
#pragma unroll
                        for (int e = 0; e < 4; ++e) { v0[e] = sigm(v0[e]); v1[e] = sigm(v1[e]); } }
                    *(u32x4*)(rowp + bj * HALF) = pack8(v0, v1);
                    if (kind == 0) {
                        float ss = (v0[0] * v0[0] + v0[1] * v0[1]) + (v0[2] * v0[2] + v0[3] * v0[3]) + (v1[0] * v1[0] + v1[1] * v1[1]) + (v1[2] * v1[2] + v1[3] * v1[3]);
                        ss += __shfl_xor(ss, 16); ss += __shfl_xor(ss, 32);
                        const int t = (u.pn == 0) ? 0 : (u.pn == 1 ? bj : (bj == 0 ? 1 : -1));
                        if (fq == 0 && t >= 0) atomicAdd(SUMSQ + (size_t)row * 2 + t, ss);
                    } } }
    }
};
struct EpiQ {
    static constexpr bool PERM = false;
    bf16_t* Q; const float* SUMSQ; const float* ROPET;
    __device__ __forceinline__ void operator()(const AccT& acc, const Unit& u, int wr, int wc, int fr, int fq) const {
        const int row0 = u.pm * BM + wr * 64 + fr;
#pragma unroll
        for (int ai = 0; ai < 2; ++ai)
#pragma unroll
            for (int m = 0; m < 4; ++m) { const int row = row0 + ai * HALF + m * 16; const int pos = row & (SEQ - 1);
                const float rs = rsqrtf(SUMSQ[(size_t)row * 2] * (1.0f / QLORA) + RMS_EPS) * QSCALE;
#pragma unroll
                for (int bj = 0; bj < 2; ++bj) { const int g32 = u.pn * 8 + bj * 4 + wc; const bool rope = (g32 % 3) == 2;
                    f32x4 v0 = acc[ai][bj][m][0] * rs, v1 = acc[ai][bj][m][1] * rs;
                    if (rope) { const f32x4 c0 = *(const f32x4*)(ROPET + (size_t)(pos * 16 + 4 * fq) * 2), c1 = *(const f32x4*)(ROPET + (size_t)(pos * 16 + 4 * fq) * 2 + 4);
                        const float cs[4] = {c0[0], c0[2], c1[0], c1[2]}, sn[4] = {c0[1], c0[3], c1[1], c1[3]};
                        f32x4 o0, o1;
#pragma unroll
                        for (int e = 0; e < 4; ++e) { o0[e] = v0[e] * cs[e] - v1[e] * sn[e]; o1[e] = v0[e] * sn[e] + v1[e] * cs[e]; }
                        v0 = o0; v1 = o1; }
                    bf16_t* p = Q + (size_t)row * 768 + u.pn * BM + bj * HALF + wc * 32 + 4 * fq;
                    u32x2 w0, w1; w0.x = cvt_pk_bf16(v0[0], v0[1]); w0.y = cvt_pk_bf16(v0[2], v0[3]); w1.x = cvt_pk_bf16(v1[0], v1[1]); w1.y = cvt_pk_bf16(v1[2], v1[3]);
                    *(u32x2*)p = w0; *(u32x2*)(p + 16) = w1; }
                asm volatile("" ::: "memory"); __builtin_amdgcn_sched_barrier(0); }
    }
};
struct EpiKV {
    static constexpr bool PERM = true;
    bf16_t* KV; const float* SUMSQ;
    __device__ __forceinline__ void operator()(const AccT& acc, const Unit& u, int wr, int wc, int fr, int fq) const {
        const int row0 = u.pm * BM + wr * 64 + fr, col0 = u.pn * BM + wc * 32 + 8 * fq;
#pragma unroll
        for (int ai = 0; ai < 2; ++ai)
#pragma unroll
            for (int m = 0; m < 4; ++m) { const int row = row0 + ai * HALF + m * 16;
                const float rs = rsqrtf(SUMSQ[(size_t)row * 2 + 1] * (1.0f / KVLORA) + RMS_EPS);
#pragma unroll
                for (int bj = 0; bj < 2; ++bj) *(u32x4*)(KV + (size_t)row * 1024 + col0 + bj * HALF) = pack8(acc[ai][bj][m][0] * rs, acc[ai][bj][m][1] * rs);
                asm volatile("" ::: "memory"); }
    }
};
struct EpiMix {
    static constexpr bool PERM = true;
    const bf16_t* GATES; bf16_t* T; bf16_t* MIXIN;
    __device__ __forceinline__ void operator()(const AccT& acc, const Unit& u, int wr, int wc, int fr, int fq) const {
        const bool second = u.pm >= 128; const int pm = second ? u.pm - 128 : u.pm, pn = second ? u.pn - 4 : u.pn;
        const int row0 = pm * BM + wr * 64 + fr, col0 = pn * BM + wc * 32 + 8 * fq;
#pragma unroll
        for (int ai = 0; ai < 2; ++ai)
#pragma unroll
            for (int m = 0; m < 4; ++m) { const int row = row0 + ai * HALF + m * 16;
#pragma unroll
                for (int bj = 0; bj < 2; ++bj) { const int col = col0 + bj * HALF;
                    const u32x4 g = *(const u32x4*)(GATES + (size_t)row * GATEW + (second ? 1024 : 0) + col);
                    f32x4 v0 = acc[ai][bj][m][0], v1 = acc[ai][bj][m][1];
                    v0[0] *= lo16(g.x); v0[1] *= hi16(g.x); v0[2] *= lo16(g.y); v0[3] *= hi16(g.y); v1[0] *= lo16(g.z); v1[1] *= hi16(g.z); v1[2] *= lo16(g.w); v1[3] *= hi16(g.w);
                    if (second) { const u32x4 t = *(const u32x4*)(T + (size_t)row * 1024 + col);
                        v0[0] += lo16(t.x); v0[1] += hi16(t.x); v0[2] += lo16(t.y); v0[3] += hi16(t.y); v1[0] += lo16(t.z); v1[1] += hi16(t.z); v1[2] += lo16(t.w); v1[3] += hi16(t.w);
                        *(u32x4*)(MIXIN + (size_t)row * 1024 + col) = pack8(v0, v1); }
                    else *(u32x4*)(T + (size_t)row * 1024 + col) = pack8(v0, v1); } }
    }
};
struct EpiRes {
    static constexpr bool PERM = false;
    const float* base; float* out;
    __device__ __forceinline__ void operator()(const AccT& acc, const Unit& u, int wr, int wc, int fr, int fq) const {
        const int row0 = u.pm * BM + wr * 64 + fr, col0 = u.pn * BM + wc * 32 + 4 * fq;
#pragma unroll
        for (int ai = 0; ai < 2; ++ai)
#pragma unroll
            for (int m = 0; m < 4; ++m) { const size_t off = (size_t)(row0 + ai * HALF + m * 16) * DM + col0;
#pragma unroll
                for (int bj = 0; bj < 2; ++bj)
#pragma unroll
                    for (int n = 0; n < 2; ++n) { const f32x4 bs = *(const f32x4*)(base + off + bj * HALF + n * 16); *(f32x4*)(out + off + bj * HALF + n * 16) = bs * ALPHA + acc[ai][bj][m][n]; } }
    }
};
struct EpiSqRelu {
    static constexpr bool PERM = true;
    bf16_t* H;
    __device__ __forceinline__ void operator()(const AccT& acc, const Unit& u, int wr, int wc, int fr, int fq) const {
        const int row0 = u.pm * BM + wr * 64 + fr, col0 = u.pn * BM + wc * 32 + 8 * fq;
#pragma unroll
        for (int ai = 0; ai < 2; ++ai)
#pragma unroll
            for (int m = 0; m < 4; ++m) { bf16_t* rowp = H + (size_t)(row0 + ai * HALF + m * 16) * DFF + col0;
#pragma unroll
                for (int bj = 0; bj < 2; ++bj) { f32x4 v0 = acc[ai][bj][m][0], v1 = acc[ai][bj][m][1];
#pragma unroll
                    for (int e = 0; e < 4; ++e) { const float a = fmaxf(v0[e], 0.f), b = fmaxf(v1[e], 0.f); v0[e] = a * a; v1[e] = b * b; }
                    *(u32x4*)(rowp + bj * HALF) = pack8(v0, v1); } }
    }
};
}

#ifndef F_IN
#define F_IN 1
#endif
#ifndef F_UP
#define F_UP 1
#endif
#ifndef F_MIX
#define F_MIX 1
#endif
#ifndef F_OUT
#define F_OUT 1
#endif
#ifndef F_FF1
#define F_FF1 1
#endif
#ifndef F_FF2
#define F_FF2 1
#endif
#ifndef F_SKIPATTN
#define F_SKIPATTN 0
#endif
__device__ __forceinline__ void kr_rope(Ctx& C) {
    for (long idx = C.gt; idx < (long)M * 16; idx += C.ngt) {
        const int m = (int)(idx >> 4), j = (int)(idx & 15), pos = m % SEQ;
        const float c = C.ROPET[2 * (pos * 16 + j)], s = C.ROPET[2 * (pos * 16 + j) + 1];
        const float t1 = bf2f(C.PS[(size_t)m * PSW + 640 + j]), t2 = bf2f(C.PS[(size_t)m * PSW + 656 + j]);
        C.KR[(size_t)m * 32 + j] = (bf16_t)f2bf(t1 * c - t2 * s); C.KR[(size_t)m * 32 + 16 + j] = (bf16_t)f2bf(t1 * s + t2 * c);
    }
}

constexpr int NTHREADS = 512;
constexpr int LDS_BYTES = 147456;
constexpr int NPHASES = 12;

__global__ void __launch_bounds__(NTHREADS, 2) fwd_megakernel(Args args) {
    extern __shared__ __attribute__((aligned(16))) unsigned char lds_raw[];
    LAS unsigned char* lds = (LAS unsigned char*)lds_raw;
    cg::grid_group grid = cg::this_grid();
    Ctx C;
    C.tid = threadIdx.x; C.lane = C.tid & 63; C.wave = __builtin_amdgcn_readfirstlane(C.tid >> 6);
    C.gw = blockIdx.x * (NTHREADS / 64) + C.wave; C.ngw = gridDim.x * (NTHREADS / 64);
    C.gt = (long)blockIdx.x * NTHREADS + C.tid; C.ngt = (long)gridDim.x * NTHREADS;
    C.x = args.in[0]; C.w_in = args.in[1]; C.b_gate = args.in[2]; C.g_q_a = args.in[3]; C.w_uq = args.in[4]; C.g_kv_a = args.in[5]; C.w_ukv = args.in[6];
    C.w_o_mla = args.in[7]; C.w_o_dil = args.in[8]; C.w_out = args.in[9]; C.ln1_g = args.in[10]; C.ln1_b = args.in[11]; C.w_ff1 = args.in[12]; C.w_ff2 = args.in[13];
    C.ln2_g = args.in[14]; C.ln2_b = args.in[15]; C.out = args.out; C.ws = args.ws;
    unsigned char* ws = args.ws;
    C.WIN = (bf16_t*)(ws + WS_WIN); C.WUQ = (bf16_t*)(ws + WS_WUQ); C.WUKV = (bf16_t*)(ws + WS_WUKV); C.WOAB = (bf16_t*)(ws + WS_WOAB); C.WOUT = (bf16_t*)(ws + WS_WOUT);
    C.WFF1 = (bf16_t*)(ws + WS_WFF1); C.WFF2 = (bf16_t*)(ws + WS_WFF2); C.ROPET = (float*)(ws + WS_ROPE); C.SUMSQ = (float*)(ws + WS_SUMSQ);
    C.PS = (bf16_t*)(ws + WS_PS); C.QKVD = (bf16_t*)(ws + WS_QKVD); C.GATES = (bf16_t*)(ws + WS_GATES); C.XB = (bf16_t*)(ws + WS_XB); C.Q = C.XB; C.MIXIN = C.XB;
    C.KV = (bf16_t*)(ws + WS_KV); C.T = C.KV; C.HB = C.KV; C.OAB = (bf16_t*)(ws + WS_OAB); C.KR = (bf16_t*)(ws + WS_KR); C.HID = (bf16_t*)(ws + WS_HID);

    const int G = gridDim.x, cu = blockIdx.x;
#define SYNC() grid.sync()
    p0_prologue(C, lds); SYNC();
#if F_IN
    { pg8::Gemm g{C.XB, C.WIN, DM, DM, DM}; pg8::StaticOrder S; S.init(M, NIN, G, cu);
      pg8::EpiIn E{C.PS, C.QKVD, C.GATES, C.b_gate, C.SUMSQ};
      pg8::gemm_phase<pg8::EpiIn, pg8::StaticOrder, true>(lds, g, S, E); }
    SYNC();
#else
    p1_naive(C); SYNC();
#endif
#if F_UP
#ifndef T_NOQ
    { pg8::Gemm g{C.PS, C.WUQ, QLORA, PSW, QLORA}; pg8::StaticOrder S; S.init(M, 768, G, cu);
      pg8::EpiQ E{C.Q, C.SUMSQ, C.ROPET};
      pg8::gemm_phase<pg8::EpiQ, pg8::StaticOrder, true>(lds, g, S, E); }
#endif
#ifndef T_NOKV
    { pg8::Gemm g{C.PS + QLORA, C.WUKV, KVLORA, PSW, KVLORA}; pg8::StaticOrder S; S.init(M, 1024, G, cu);
      pg8::EpiKV E{C.KV, C.SUMSQ};
      pg8::gemm_phase<pg8::EpiKV, pg8::StaticOrder, true>(lds, g, S, E); }
#endif
    kr_rope(C);
    SYNC();
#else
    p2_naive(C); SYNC();
    p2b_naive_qrope(C); SYNC();
#endif
#if !F_SKIPATTN
    p3_naive_mla(C); p3_naive_dil(C);
#endif
    SYNC();
#if F_MIX
    { pg8::Gemm g{C.OAB, C.WOAB, 512, 512, 512}; pg8::PairOrder S; S.init(M, 1024, G, cu);
      pg8::EpiMix E{C.GATES, C.T, C.MIXIN};
      pg8::gemm_phase<pg8::EpiMix, pg8::PairOrder, true>(lds, g, S, E); }
    SYNC();
#else
    p4_naive(C); SYNC();
    p4b_naive(C); SYNC();
#endif
#if F_OUT
    { pg8::Gemm g{C.MIXIN, C.WOUT, DM, DM, DM}; pg8::StaticOrder S; S.init(M, DM, G, cu);
      pg8::EpiRes E{C.x, C.out};
      pg8::gemm_phase<pg8::EpiRes, pg8::StaticOrder, true>(lds, g, S, E); }
    SYNC();
#else
    p5_naive(C); SYNC();
#endif
    ln_rows(C, C.ln1_g, C.ln1_b, C.HB); SYNC();
#if F_FF1
    { pg8::Gemm g{C.HB, C.WFF1, DM, DM, DM}; pg8::StaticOrder S; S.init(M, DFF, G, cu);
      pg8::EpiSqRelu E{C.HID};
      pg8::gemm_phase<pg8::EpiSqRelu, pg8::StaticOrder, true>(lds, g, S, E); }
    SYNC();
#else
    p7_naive(C); SYNC();
#endif
#if F_FF2
    { pg8::Gemm g{C.HID, C.WFF2, DFF, DFF, DFF}; pg8::StaticOrder S; S.init(M, DM, G, cu);
      pg8::EpiRes E{C.out, C.out};
      pg8::gemm_phase<pg8::EpiRes, pg8::StaticOrder, true>(lds, g, S, E); }
    SYNC();
#else
    p8_naive(C); SYNC();
#endif
    ln_rows(C, C.ln2_g, C.ln2_b, nullptr);
#undef SYNC
}

extern "C" void kernel_launch(void* const* d_in, const int* in_sizes, int n_in, void* d_out, int out_size, void* d_ws, size_t ws_size, hipStream_t stream) {
    static int grid = 0;
    if (grid == 0) {
        if (n_in != 16 || in_sizes[0] != M * DM || out_size != M * DM || ws_size < WS_END) {
            fprintf(stderr, "kernel_launch: unexpected shapes: n_in %d in0 %d out %d ws %zu (need >= %zu)\n", n_in, n_in > 0 ? in_sizes[0] : -1, out_size, ws_size, (size_t)WS_END);
            grid = -1; return;
        }
        int dev = 0, cus = 0, per_cu = 0;
        (void)hipGetDevice(&dev);
        (void)hipDeviceGetAttribute(&cus, hipDeviceAttributeMultiprocessorCount, dev);
        (void)hipFuncSetAttribute((const void*)fwd_megakernel, hipFuncAttributeMaxDynamicSharedMemorySize, LDS_BYTES);
        (void)hipOccupancyMaxActiveBlocksPerMultiprocessor(&per_cu, (const void*)fwd_megakernel, NTHREADS, LDS_BYTES);
        if (per_cu < 1) { fprintf(stderr, "kernel_launch: occupancy query returned %d\n", per_cu); per_cu = 1; }
        (void)hipGetLastError();
        grid = cus * per_cu;
    }
    if (grid < 0) return;
    Args a{};
    for (int i = 0; i < 16; ++i) a.in[i] = (const float*)d_in[i];
    a.out = (float*)d_out; a.ws = (unsigned char*)d_ws; a.ph_lo = 0; a.ph_hi = NPHASES;
    void* kargs[] = {&a};
    hipError_t e = hipLaunchCooperativeKernel((const void*)fwd_megakernel, dim3(grid), dim3(NTHREADS), kargs, LDS_BYTES, stream);
    if (e != hipSuccess) fprintf(stderr, "cooperative launch failed: %s (grid %d)\n", hipGetErrorString(e), grid);
}
```

```cpp
#include <hip/hip_runtime.h>
#include <hip/hip_cooperative_groups.h>
#include <cstdio>
#include <cstdint>
namespace cg = cooperative_groups;

#define LAS __attribute__((address_space(3)))
typedef unsigned short bf16_t;
typedef float f32x4 __attribute__((ext_vector_type(4)));
typedef unsigned u32x4 __attribute__((ext_vector_type(4)));
typedef unsigned u32x2 __attribute__((ext_vector_type(2)));

constexpr int BATCH = 16, SEQ = 2048, DM = 1024, M = BATCH * SEQ;
constexpr int NH = 8;
constexpr int QLORA = 384, KVLORA = 256, ROPE = 32, NOPE = 64, VD = 64, QK = 96;
constexpr int NIN = 4352;
constexpr int PSW = 768, QKVDW = 1536, GATEW = 2048;
constexpr int DFF = 4096;
constexpr float LN_EPS = 1e-5f, RMS_EPS = 1e-6f;
constexpr float ALPHA = 1.189207115002721f;
constexpr float LOG2E = 1.4426950408889634f;
constexpr float QSCALE = 0.10206207261596577f * LOG2E;

constexpr size_t MiB = 1u << 20;
constexpr size_t WS_WIN = 2 * MiB;
constexpr size_t WS_WUQ = 11 * MiB;
constexpr size_t WS_WUKV = 12 * MiB;
constexpr size_t WS_WOAB = 13 * MiB;
constexpr size_t WS_WOUT = 15 * MiB;
constexpr size_t WS_WFF1 = 17 * MiB;
constexpr size_t WS_WFF2 = 25 * MiB;
constexpr size_t WS_ROPE = 33 * MiB;
constexpr size_t WS_SUMSQ = 33 * MiB + 512 * 1024;
constexpr size_t WS_PS = 34 * MiB;
constexpr size_t WS_QKVD = 82 * MiB;
constexpr size_t WS_GATES = 178 * MiB;
constexpr size_t WS_XB = 306 * MiB;
constexpr size_t WS_KV = 370 * MiB;
constexpr size_t WS_OAB = 434 * MiB;
constexpr size_t WS_KR = 498 * MiB;
constexpr size_t WS_HID = 34 * MiB;
constexpr size_t WS_END = 500 * MiB;

__device__ __forceinline__ float bf2f(bf16_t v) { return __uint_as_float((unsigned)v << 16); }
__device__ __forceinline__ unsigned f2bf(float f) { unsigned u = __float_as_uint(f); return (u + 0x7fffu + ((u >> 16) & 1u)) >> 16; }
__device__ __forceinline__ unsigned pk2(float lo, float hi) { return f2bf(lo) | (f2bf(hi) << 16); }
__device__ __forceinline__ float lo16(unsigned u) { return __uint_as_float(u << 16); }
__device__ __forceinline__ float hi16(unsigned u) { return __uint_as_float(u & 0xffff0000u); }
__device__ __forceinline__ float wave_sum(float v) {
#pragma unroll
    for (int o = 1; o < 64; o <<= 1) v += __shfl_xor(v, o);
    return v;
}

struct Args { const float* in[16]; float* out; unsigned char* ws; int ph_lo, ph_hi; };

struct Ctx {
    int tid, lane, wave, gw, ngw; long gt, ngt;
    const float *x, *w_in, *b_gate, *g_q_a, *w_uq, *g_kv_a, *w_ukv, *w_o_mla, *w_o_dil, *w_out, *ln1_g, *ln1_b, *w_ff1, *w_ff2, *ln2_g, *ln2_b;
    float* out; unsigned char* ws;
    bf16_t *WIN, *WUQ, *WUKV, *WOAB, *WOUT, *WFF1, *WFF2, *PS, *QKVD, *GATES, *XB, *Q, *MIXIN, *KV, *T, *HB, *OAB, *KR, *HID;
    float* ROPET; float* SUMSQ;
};

__device__ __forceinline__ void transpose_item(const float* W, int Nsrc, int src_n0, const float* kscale, bf16_t* WT, int K, int dst_n0, int k0, LAS float* scr, int lane) {
#pragma unroll 8
    for (int i = 0; i < 32; ++i) {
        const int kk = 2 * i + (lane >> 5);
        float v = 0.f;
        if (src_n0 >= 0) { v = W[(size_t)(k0 + kk) * Nsrc + src_n0 + (lane & 31)]; if (kscale) v *= kscale[k0 + kk]; }
        scr[kk * 33 + (lane & 31)] = v;
    }
    asm volatile("s_waitcnt lgkmcnt(0)" ::: "memory");
    const int c = lane & 7;
#pragma unroll
    for (int j = 0; j < 4; ++j) {
        const int n = (lane >> 3) + 8 * j; const LAS float* s = scr + (8 * c) * 33 + n;
        u32x4 o; o.x = pk2(s[0 * 33], s[1 * 33]); o.y = pk2(s[2 * 33], s[3 * 33]); o.z = pk2(s[4 * 33], s[5 * 33]); o.w = pk2(s[6 * 33], s[7 * 33]);
        *(u32x4*)(WT + (size_t)(dst_n0 + n) * K + k0 + 8 * c) = o;
    }
    asm volatile("s_waitcnt lgkmcnt(0)" ::: "memory");
}
__device__ __forceinline__ bool tr_matrix(int& r, const float* W, int K, int Nsrc, int Ndst, bool in_map, const float* kscale, bf16_t* WT, int dst_row_off, LAS float* scr, int lane) {
    const int nblk = Ndst / 32, items = (K / 64) * nblk;
    if (r >= items) { r -= items; return false; }
    const int kb = r / nblk, nb = r % nblk, n0 = nb * 32;
    int src = n0;
    if (in_map) src = (n0 < 672) ? n0 : (n0 < 768 ? -1 : n0 - 96);
    transpose_item(W, Nsrc, src, kscale, WT, K, dst_row_off + n0, kb * 64, scr, lane);
    return true;
}
__device__ __forceinline__ void p0_prologue(Ctx& C, LAS unsigned char* lds) {
    LAS float* scr = (LAS float*)(lds + C.wave * 16384);
    constexpr int NITEMS = 16 * 136 + 6 * 24 + 4 * 32 + 8 * 32 + 8 * 32 + 16 * 32 + 16 * 128 + 64 * 32;
    for (int it = C.gw; it < NITEMS; it += C.ngw) {
        int r = it;
        if (tr_matrix(r, C.w_in, 1024, 4256, NIN, true, nullptr, C.WIN, 0, scr, C.lane)) continue;
        if (tr_matrix(r, C.w_uq, QLORA, 768, 768, false, C.g_q_a, C.WUQ, 0, scr, C.lane)) continue;
        if (tr_matrix(r, C.w_ukv, KVLORA, 1024, 1024, false, C.g_kv_a, C.WUKV, 0, scr, C.lane)) continue;
        if (tr_matrix(r, C.w_o_mla, 512, 1024, 1024, false, nullptr, C.WOAB, 0, scr, C.lane)) continue;
        if (tr_matrix(r, C.w_o_dil, 512, 1024, 1024, false, nullptr, C.WOAB, 1024, scr, C.lane)) continue;
        if (tr_matrix(r, C.w_out, 1024, 1024, 1024, false, nullptr, C.WOUT, 0, scr, C.lane)) continue;
        if (tr_matrix(r, C.w_ff1, 1024, 4096, 4096, false, nullptr, C.WFF1, 0, scr, C.lane)) continue;
        tr_matrix(r, C.w_ff2, 4096, 1024, 1024, false, nullptr, C.WFF2, 0, scr, C.lane);
    }
    {
        const f32x4* xs = (const f32x4*)C.x; u32x2* xd = (u32x2*)C.XB; const long n4 = (long)M * DM / 4;
        for (long i = C.gt; i < n4; i += C.ngt) { const f32x4 v = xs[i]; u32x2 o; o.x = pk2(v.x, v.y); o.y = pk2(v.z, v.w); xd[i] = o; }
    }
    for (long i = C.gt; i < SEQ * 16; i += C.ngt) {
        const int pos = (int)(i >> 4), j = (int)(i & 15);
        const float inv = powf(10000.0f, -(float)j / 16.0f); const float ang = (float)pos * inv;
        C.ROPET[2 * i] = cosf(ang); C.ROPET[2 * i + 1] = sinf(ang);
    }
    for (long i = C.gt; i < (long)M * 2; i += C.ngt) C.SUMSQ[i] = 0.f;
}

template <class F> __device__ __forceinline__ void naive_gemm(Ctx& C, const bf16_t* A, int lda, const bf16_t* Bt, int ldb, int Mr, int N, int K, F epi) {
    const int n4 = N / 4; const long total = (long)Mr * n4;
    for (long idx = C.gt; idx < total; idx += C.ngt) {
        const int m = (int)(idx / n4), n0 = (int)(idx % n4) * 4;
        float a0 = 0.f, a1 = 0.f, a2 = 0.f, a3 = 0.f, ss = 0.f;
        const bf16_t* ar = A + (size_t)m * lda; const bf16_t* br = Bt + (size_t)n0 * ldb;
        for (int k = 0; k < K; k += 8) {
            const u32x4 av = *(const u32x4*)(ar + k);
            const u32x4 b0 = *(const u32x4*)(br + k), b1 = *(const u32x4*)(br + ldb + k), b2 = *(const u32x4*)(br + 2 * ldb + k), b3 = *(const u32x4*)(br + 3 * ldb + k);
#pragma unroll
            for (int e = 0; e < 4; ++e) {
                const float al = lo16(av[e]), ah = hi16(av[e]);
                ss += al * al + ah * ah;
                a0 += al * lo16(b0[e]) + ah * hi16(b0[e]); a1 += al * lo16(b1[e]) + ah * hi16(b1[e]);
                a2 += al * lo16(b2[e]) + ah * hi16(b2[e]); a3 += al * lo16(b3[e]) + ah * hi16(b3[e]);
            }
        }
        epi(m, n0, a0, a1, a2, a3, ss);
    }
}
__device__ __forceinline__ float sigmoidf_(float v) { return 1.0f / (1.0f + __expf(-v)); }

__device__ __forceinline__ void p1_naive(Ctx& C) {
    naive_gemm(C, C.XB, DM, C.WIN, DM, M, NIN, DM, [&](int m, int n0, float a0, float a1, float a2, float a3, float) {
        u32x2 o;
        if (n0 < PSW) { o.x = pk2(a0, a1); o.y = pk2(a2, a3); *(u32x2*)(C.PS + (size_t)m * PSW + n0) = o; }
        else if (n0 < PSW + QKVDW) { o.x = pk2(a0, a1); o.y = pk2(a2, a3); *(u32x2*)(C.QKVD + (size_t)m * QKVDW + (n0 - PSW)) = o; }
        else { const int g = n0 - PSW - QKVDW; const f32x4 b = *(const f32x4*)(C.b_gate + g);
            o.x = pk2(sigmoidf_(a0 + b.x), sigmoidf_(a1 + b.y)); o.y = pk2(sigmoidf_(a2 + b.z), sigmoidf_(a3 + b.w)); *(u32x2*)(C.GATES + (size_t)m * GATEW + g) = o; }
    });
}
__device__ __forceinline__ void p2_naive(Ctx& C) {
    naive_gemm(C, C.PS, PSW, C.WUQ, QLORA, M, 768, QLORA, [&](int m, int n0, float a0, float a1, float a2, float a3, float ss) {
        const float rs = rsqrtf(ss * (1.0f / QLORA) + RMS_EPS) * QSCALE;
        u32x2 o; o.x = pk2(a0 * rs, a1 * rs); o.y = pk2(a2 * rs, a3 * rs); *(u32x2*)(C.Q + (size_t)m * 768 + n0) = o;
    });
    naive_gemm(C, C.PS + QLORA, PSW, C.WUKV, KVLORA, M, 1024, KVLORA, [&](int m, int n0, float a0, float a1, float a2, float a3, float ss) {
        const float rs = rsqrtf(ss * (1.0f / KVLORA) + RMS_EPS);
        u32x2 o; o.x = pk2(a0 * rs, a1 * rs); o.y = pk2(a2 * rs, a3 * rs); *(u32x2*)(C.KV + (size_t)m * 1024 + n0) = o;
    });
    for (long idx = C.gt; idx < (long)M * 16; idx += C.ngt) {
        const int m = (int)(idx >> 4), j = (int)(idx & 15), pos = m % SEQ;
        const float c = C.ROPET[2 * (pos * 16 + j)], s = C.ROPET[2 * (pos * 16 + j) + 1];
        const float t1 = bf2f(C.PS[(size_t)m * PSW + 640 + j]), t2 = bf2f(C.PS[(size_t)m * PSW + 656 + j]);
        C.KR[(size_t)m * 32 + j] = (bf16_t)f2bf(t1 * c - t2 * s); C.KR[(size_t)m * 32 + 16 + j] = (bf16_t)f2bf(t1 * s + t2 * c);
    }
}
__device__ __forceinline__ void p2b_naive_qrope(Ctx& C) {
    for (long idx = C.gt; idx < (long)M * NH * 16; idx += C.ngt) {
        const int j = (int)(idx & 15), h = (int)((idx >> 4) & 7), m = (int)(idx >> 7), pos = m % SEQ;
        const float c = C.ROPET[2 * (pos * 16 + j)], s = C.ROPET[2 * (pos * 16 + j) + 1];
        bf16_t* p = C.Q + (size_t)m * 768 + h * 96 + 64 + j;
        const float t1 = bf2f(p[0]), t2 = bf2f(p[16]);
        p[0] = (bf16_t)f2bf(t1 * c - t2 * s); p[16] = (bf16_t)f2bf(t1 * s + t2 * c);
    }
}

__device__ __forceinline__ void p3_naive_mla(Ctx& C) {
    for (long idx = C.gt; idx < (long)BATCH * NH * SEQ; idx += C.ngt) {
        const int q = (int)(idx % SEQ), h = (int)((idx / SEQ) % NH), b = (int)(idx / (SEQ * NH));
        const size_t m = (size_t)b * SEQ + q;
        u32x4 qv[12];
#pragma unroll
        for (int i = 0; i < 12; ++i) qv[i] = *(const u32x4*)(C.Q + m * 768 + h * 96 + i * 8);
        float o[64];
#pragma unroll
        for (int d = 0; d < 64; ++d) o[d] = 0.f;
        float mx = -1e30f, l = 0.f;
        const int kmax = __builtin_amdgcn_readfirstlane(q | 63);
        for (int k = 0; k <= kmax; ++k) {
            const size_t mk = (size_t)b * SEQ + k;
            const bf16_t* kp = C.KV + mk * 1024 + h * 128; const bf16_t* rp = C.KR + mk * 32;
            float s = 0.f;
#pragma unroll
            for (int i = 0; i < 8; ++i) { const u32x4 kv = *(const u32x4*)(kp + i * 8);
#pragma unroll
                for (int e = 0; e < 4; ++e) s += lo16(qv[i][e]) * lo16(kv[e]) + hi16(qv[i][e]) * hi16(kv[e]); }
#pragma unroll
            for (int i = 0; i < 4; ++i) { const u32x4 kv = *(const u32x4*)(rp + i * 8);
#pragma unroll
                for (int e = 0; e < 4; ++e) s += lo16(qv[8 + i][e]) * lo16(kv[e]) + hi16(qv[8 + i][e]) * hi16(kv[e]); }
            if (k <= q) {
                const float mn = fmaxf(mx, s), f = exp2f(mx - mn), p = exp2f(s - mn);
                l = l * f + p; mx = mn;
#pragma unroll
                for (int i = 0; i < 8; ++i) { const u32x4 vv = *(const u32x4*)(kp + 64 + i * 8);
#pragma unroll
                    for (int e = 0; e < 4; ++e) { o[i * 8 + 2 * e] = o[i * 8 + 2 * e] * f + p * lo16(vv[e]); o[i * 8 + 2 * e + 1] = o[i * 8 + 2 * e + 1] * f + p * hi16(vv[e]); } }
            }
        }
        const float il = 1.0f / l;
        bf16_t* op = C.OAB + m * 512 + h * 64;
#pragma unroll
        for (int i = 0; i < 8; ++i) { u32x4 w; w.x = pk2(o[i * 8] * il, o[i * 8 + 1] * il); w.y = pk2(o[i * 8 + 2] * il, o[i * 8 + 3] * il); w.z = pk2(o[i * 8 + 4] * il, o[i * 8 + 5] * il); w.w = pk2(o[i * 8 + 6] * il, o[i * 8 + 7] * il); *(u32x4*)(op + i * 8) = w; }
    }
}
__device__ __forceinline__ void p3_naive_dil(Ctx& C) {
    for (long idx = C.gt; idx < (long)BATCH * NH * SEQ; idx += C.ngt) {
        const int t = (int)(idx % SEQ), h = (int)((idx / SEQ) % NH), b = (int)(idx / (SEQ * NH));
        const size_t m = (size_t)b * SEQ + t;
        const float slope = exp2f(-(float)(h + 1));
        u32x4 qv[8];
#pragma unroll
        for (int i = 0; i < 8; ++i) qv[i] = *(const u32x4*)(C.QKVD + m * QKVDW + h * 64 + i * 8);
        float num[64];
#pragma unroll
        for (int d = 0; d < 64; ++d) num[d] = 0.f;
        float m_all = -1e30f, tot = 0.f;
        for (int p = 0; p < 3; ++p) {
            const int dil = (p == 0) ? 1 : (p == 1 ? 4 : 16);
            float o[64];
#pragma unroll
            for (int d = 0; d < 64; ++d) o[d] = 0.f;
            float mx = -1e30f, l = 0.f;
            for (int j = 0; j <= 128; ++j) {
                const int tk = t - j * dil; if (tk < 0) break;
                const bf16_t* kp = C.QKVD + ((size_t)b * SEQ + tk) * QKVDW + 512 + h * 64;
                float s = 0.f;
#pragma unroll
                for (int i = 0; i < 8; ++i) { const u32x4 kv = *(const u32x4*)(kp + i * 8);
#pragma unroll
                    for (int e = 0; e < 4; ++e) s += lo16(qv[i][e]) * lo16(kv[e]) + hi16(qv[i][e]) * hi16(kv[e]); }
                s = s * 0.125f - slope * (float)(dil * j);
                const float mn = fmaxf(mx, s), f = __expf(mx - mn), pe = __expf(s - mn);
                l = l * f + pe; mx = mn;
#pragma unroll
                for (int i = 0; i < 8; ++i) { const u32x4 vv = *(const u32x4*)(kp + 512 + i * 8);
#pragma unroll
                    for (int e = 0; e < 4; ++e) { o[i * 8 + 2 * e] = o[i * 8 + 2 * e] * f + pe * lo16(vv[e]); o[i * 8 + 2 * e + 1] = o[i * 8 + 2 * e + 1] * f + pe * hi16(vv[e]); } }
            }
            const float mn = fmaxf(m_all, mx), fa = __expf(m_all - mn), fb = __expf(mx - mn);
            tot = tot * fa + l * fb; m_all = mn;
#pragma unroll
            for (int d = 0; d < 64; ++d) num[d] = num[d] * fa + o[d] * fb;
        }
        const float it = 1.0f / tot;
        bf16_t* op = C.OAB + ((size_t)M + m) * 512 + h * 64;
#pragma unroll
        for (int i = 0; i < 8; ++i) { u32x4 w; w.x = pk2(num[i * 8] * it, num[i * 8 + 1] * it); w.y = pk2(num[i * 8 + 2] * it, num[i * 8 + 3] * it); w.z = pk2(num[i * 8 + 4] * it, num[i * 8 + 5] * it); w.w = pk2(num[i * 8 + 6] * it, num[i * 8 + 7] * it); *(u32x4*)(op + i * 8) = w; }
    }
}
__device__ __forceinline__ void p4_naive(Ctx& C) {
    naive_gemm(C, C.OAB, 512, C.WOAB, 512, M, 1024, 512, [&](int m, int n0, float a0, float a1, float a2, float a3, float) {
        const u32x2 g = *(const u32x2*)(C.GATES + (size_t)m * GATEW + n0);
        u32x2 o; o.x = pk2(a0 * lo16(g.x), a1 * hi16(g.x)); o.y = pk2(a2 * lo16(g.y), a3 * hi16(g.y)); *(u32x2*)(C.T + (size_t)m * 1024 + n0) = o;
    });
}
__device__ __forceinline__ void p4b_naive(Ctx& C) {
    naive_gemm(C, C.OAB + (size_t)M * 512, 512, C.WOAB + (size_t)1024 * 512, 512, M, 1024, 512, [&](int m, int n0, float a0, float a1, float a2, float a3, float) {
        const u32x2 g = *(const u32x2*)(C.GATES + (size_t)m * GATEW + 1024 + n0); const u32x2 t = *(const u32x2*)(C.T + (size_t)m * 1024 + n0);
        u32x2 o; o.x = pk2(lo16(t.x) + a0 * lo16(g.x), hi16(t.x) + a1 * hi16(g.x)); o.y = pk2(lo16(t.y) + a2 * lo16(g.y), hi16(t.y) + a3 * hi16(g.y)); *(u32x2*)(C.MIXIN + (size_t)m * 1024 + n0) = o;
    });
}
__device__ __forceinline__ void p5_naive(Ctx& C) {
    naive_gemm(C, C.MIXIN, 1024, C.WOUT, 1024, M, 1024, 1024, [&](int m, int n0, float a0, float a1, float a2, float a3, float) {
        const f32x4 xv = *(const f32x4*)(C.x + (size_t)m * DM + n0);
        *(f32x4*)(C.out + (size_t)m * DM + n0) = (f32x4){ALPHA * xv.x + a0, ALPHA * xv.y + a1, ALPHA * xv.z + a2, ALPHA * xv.w + a3};
    });
}
__device__ __forceinline__ void ln_rows(Ctx& C, const float* g, const float* bta, bf16_t* hb) {
    for (int m = C.gw; m < M; m += C.ngw) {
        f32x4* xr = (f32x4*)(C.out + (size_t)m * DM) + C.lane;
        f32x4 v[4]; float s = 0.f;
#pragma unroll
        for (int j = 0; j < 4; ++j) { v[j] = xr[64 * j]; s += (v[j].x + v[j].y) + (v[j].z + v[j].w); }
        const float mean = wave_sum(s) * (1.f / DM); float s2 = 0.f;
#pragma unroll
        for (int j = 0; j < 4; ++j) { v[j] = v[j] - mean; s2 += (v[j].x * v[j].x + v[j].y * v[j].y) + (v[j].z * v[j].z + v[j].w * v[j].w); }
        const float rstd = rsqrtf(wave_sum(s2) * (1.f / DM) + LN_EPS);
#pragma unroll
        for (int j = 0; j < 4; ++j) {
            const f32x4 gg = ((const f32x4*)g)[C.lane + 64 * j], bb = ((const f32x4*)bta)[C.lane + 64 * j];
            const f32x4 o = v[j] * rstd * gg + bb; xr[64 * j] = o;
            if (hb) { u32x2 w; w.x = pk2(o.x, o.y); w.y = pk2(o.z, o.w); ((u32x2*)(hb + (size_t)m * DM))[C.lane + 64 * j] = w; }
        }
    }
}
__device__ __forceinline__ void p7_naive(Ctx& C) {
    naive_gemm(C, C.HB, DM, C.WFF1, DM, M, DFF, DM, [&](int m, int n0, float a0, float a1, float a2, float a3, float) {
        a0 = fmaxf(a0, 0.f); a1 = fmaxf(a1, 0.f); a2 = fmaxf(a2, 0.f); a3 = fmaxf(a3, 0.f);
        u32x2 o; o.x = pk2(a0 * a0, a1 * a1); o.y = pk2(a2 * a2, a3 * a3); *(u32x2*)(C.HID + (size_t)m * DFF + n0) = o;
    });
}
__device__ __forceinline__ void p8_naive(Ctx& C) {
    naive_gemm(C, C.HID, DFF, C.WFF2, DFF, M, DM, DFF, [&](int m, int n0, float a0, float a1, float a2, float a3, float) {
        f32x4* p = (f32x4*)(C.out + (size_t)m * DM + n0); const f32x4 hv = *p;
        *p = (f32x4){ALPHA * hv.x + a0, ALPHA * hv.y + a1, ALPHA * hv.z + a2, ALPHA * hv.w + a3};
    });
}

namespace pg8 {
typedef short bf16x8 __attribute__((ext_vector_type(8)));
constexpr int BM = 256, BK = 64, HALF = 128, HTB = HALF * BK * 2, STAGE_BYTES = 8 * HTB, NXCD = 8, WGM = 8;
__host__ __device__ __forceinline__ int lds_byte(int r, int c) { const int st = (r >> 4) * 2 + (c >> 5), rr = r & 15, cc = c & 31, ob = rr * 64 + cc * 2; return st * 1024 + (ob ^ (((ob >> 9) & 1) << 5)); }
__host__ __device__ __forceinline__ void stage_rc(int b, int& R, int& C) { const int st = b / 1024, sb = b % 1024, swz = sb ^ (((sb >> 9) & 1) << 5); R = (st >> 1) * 16 + swz / 64; C = (st & 1) * 32 + (swz % 64) / 2; }
__host__ __device__ __forceinline__ int perm32(int rho) { const int n = rho >> 4, i = rho & 15; return 8 * (i >> 2) + 4 * n + (i & 3); }
struct Unit { int pm, pn; };
struct Gemm { const bf16_t* A; const bf16_t* Bt; int K, lda, ldb; };
__device__ __forceinline__ void swz_tile(int L, int nM, int nN, Unit& u) {
    const int nwg = nM * nN; int wgid = L;
    { const int q = nwg / NXCD, r = nwg % NXCD, xcd = wgid % NXCD, off = wgid / NXCD; wgid = (xcd < r ? xcd * (q + 1) : r * (q + 1) + (xcd - r) * q) + off; }
    const int nig = WGM * nN, gid = wgid / nig, fm = gid * WGM, gsz = (nM - fm) < WGM ? (nM - fm) : WGM;
    u.pm = fm + ((wgid % nig) % gsz); u.pn = (wgid % nig) / gsz;
}
struct StaticOrder {
    int nM, nN, nwg, G, c;
    __device__ void init(int Mr, int N, int G_, int c_) { nM = Mr / BM; nN = N / BM; nwg = nM * nN; G = G_; c = c_; }
    __device__ bool next(int i, Unit& u) const { const long L = (long)i * G + c; if (L >= nwg) return false; swz_tile((int)L, nM, nN, u); return true; }
};
struct PairOrder {
    int nM, nN, nwg, G, c;
    __device__ void init(int Mr, int N, int G_, int c_) { nM = Mr / BM; nN = N / BM; nwg = nM * nN; G = G_; c = c_; }
    __device__ bool next(int i, Unit& u) const { const long L = (long)(i >> 1) * G + c; if (L >= nwg) return false; swz_tile((int)L, nM, nN, u); if (i & 1) { u.pm += nM; u.pn += nN; } return true; }
};
__device__ __forceinline__ unsigned cvt_pk_bf16(float lo, float hi) { unsigned r; asm volatile("v_cvt_pk_bf16_f32 %0, %1, %2" : "=v"(r) : "v"(lo), "v"(hi)); return r; }

template <class Epi, class Sched, bool ALIGN_EPI>
__device__ __forceinline__ void gemm_phase(LAS unsigned char* lds, const Gemm g, const Sched& S, const Epi& E) {
    const int tid = threadIdx.x, wid = __builtin_amdgcn_readfirstlane(tid >> 6), lane = tid & 63, wr = wid >> 2, wc = wid & 3, fr = lane & 15, fq = lane >> 4;
    const int K = g.K, nt = K / BK;
    unsigned voffA[2], voffB[2];
#pragma unroll
    for (int i = 0; i < 2; ++i) { int R, C; stage_rc(tid * 16 + i * 8192, R, C); const int Rb = Epi::PERM ? ((R & ~31) + perm32(R & 31)) : R;
        voffA[i] = (unsigned)(R * g.lda + C) * 2u; voffB[i] = (unsigned)(Rb * g.ldb + C) * 2u; }
    const size_t kstep = (size_t)(BK * 2);
    const size_t hstepA = (size_t)HALF * g.lda * 2, hstepB = (size_t)HALF * g.ldb * 2;
    const size_t tstepA = 2 * hstepA, tstepB = 2 * hstepB;
    const unsigned ldsw = (unsigned)wid * 1024u;
    const int aoff = lds_byte(wr * 64 + fr, fq * 8), boff = lds_byte(wc * 32 + fr, fq * 8);
#define PG8_SA(b, h) (((b) * 2 + (h)) * HTB)
#define PG8_SB(b, h) ((4 + (b) * 2 + (h)) * HTB)
#define PG8_STAGE(bufoff, gbase, voff) do { _Pragma("unroll") for (int _i = 0; _i < 2; ++_i) \
        __builtin_amdgcn_global_load_lds((const unsigned*)((const char*)(gbase) + (voff)[_i]), (LAS unsigned*)(lds + (bufoff) + ldsw + _i * 8192), 16, 0, 0); } while (0)
#define PG8_LDA(dst, b, h) do { _Pragma("unroll") for (int m = 0; m < 4; ++m) _Pragma("unroll") for (int k = 0; k < 2; ++k) dst[m][k] = *(const LAS bf16x8*)(lds + PG8_SA(b, h) + aoff + m * 2048 + k * 1024); } while (0)
#define PG8_LDB(dst, b, h) do { _Pragma("unroll") for (int n = 0; n < 2; ++n) _Pragma("unroll") for (int k = 0; k < 2; ++k) dst[n][k] = *(const LAS bf16x8*)(lds + PG8_SB(b, h) + boff + n * 2048 + k * 1024); } while (0)
#define PG8_MMA(ai, bj, At, Bt) do { __builtin_amdgcn_s_setprio(1); _Pragma("unroll") for (int m = 0; m < 4; ++m) _Pragma("unroll") for (int n = 0; n < 2; ++n) _Pragma("unroll") for (int k = 0; k < 2; ++k) \
        acc[ai][bj][m][n] = __builtin_amdgcn_mfma_f32_16x16x32_bf16(Bt[n][k], At[m][k], acc[ai][bj][m][n], 0, 0, 0); __builtin_amdgcn_s_setprio(0); } while (0)
#define PG8_WAIT_V(n) asm volatile("s_waitcnt vmcnt(" #n ")" ::: "memory")
#define PG8_WAIT_L(n) asm volatile("s_waitcnt lgkmcnt(" #n ")" ::: "memory")
#define PG8_BAR __builtin_amdgcn_s_barrier()
#define PG8_SCHED __builtin_amdgcn_sched_barrier(0)
    Unit cur, nxt; int ui = 0;
    if (!S.next(0, cur)) return;
    f32x4 acc[2][2][4][2];
#pragma unroll
    for (int a = 0; a < 2; ++a)
#pragma unroll
        for (int b = 0; b < 2; ++b)
#pragma unroll
            for (int m = 0; m < 4; ++m)
#pragma unroll
                for (int n = 0; n < 2; ++n) acc[a][b][m][n] = (f32x4){0.f, 0.f, 0.f, 0.f};
    bf16x8 At[4][2], B0[2][2], B1[2][2];
    const char* cA = (const char*)g.A + (size_t)cur.pm * tstepA; const char* cB = (const char*)g.Bt + (size_t)cur.pn * tstepB;
    PG8_STAGE(PG8_SB(0, 0), cB, voffB); PG8_STAGE(PG8_SB(0, 1), cB + hstepB, voffB); PG8_STAGE(PG8_SA(0, 0), cA, voffA); PG8_STAGE(PG8_SA(0, 1), cA + hstepA, voffA);
    if (wr == 1) PG8_BAR;
    PG8_WAIT_V(2); PG8_BAR;
    PG8_STAGE(PG8_SB(1, 0), cB + kstep, voffB); PG8_STAGE(PG8_SA(1, 0), cA + kstep, voffA); PG8_STAGE(PG8_SB(1, 1), cB + hstepB + kstep, voffB);
    PG8_WAIT_V(6); PG8_BAR;
    for (;;) {
        const bool has_next = S.next(ui + 1, nxt);
        const char* nA = has_next ? (const char*)g.A + (size_t)nxt.pm * tstepA : cA; const char* nB = has_next ? (const char*)g.Bt + (size_t)nxt.pn * tstepB : cB;
#pragma nounroll
        for (int t = 0; t < nt; t += 2) {
            const bool last = (t == nt - 2);
            const char* a1 = cA + (size_t)(t + 1) * kstep;
            const char* a2 = last ? nA : cA + (size_t)(t + 2) * kstep; const char* b2 = last ? nB : cB + (size_t)(t + 2) * kstep;
            const char* a3 = a2 + kstep; const char* b3 = b2 + kstep;
            PG8_LDB(B0, 0, 0); PG8_LDB(B1, 0, 1); PG8_SCHED; PG8_LDA(At, 0, 0); PG8_STAGE(PG8_SA(1, 1), a1 + hstepA, voffA);
            PG8_WAIT_V(8); PG8_WAIT_L(0); PG8_BAR; PG8_MMA(0, 0, At, B0); PG8_MMA(0, 1, At, B1); PG8_BAR; PG8_SCHED;
            PG8_LDA(At, 0, 1); PG8_STAGE(PG8_SB(0, 0), b2, voffB); PG8_STAGE(PG8_SB(0, 1), b2 + hstepB, voffB); PG8_STAGE(PG8_SA(0, 0), a2, voffA);
            PG8_WAIT_V(8); PG8_WAIT_L(0); PG8_BAR; PG8_MMA(1, 0, At, B0); PG8_MMA(1, 1, At, B1); PG8_BAR; PG8_SCHED;
            PG8_LDB(B0, 1, 0); PG8_LDB(B1, 1, 1); PG8_SCHED; PG8_LDA(At, 1, 0); PG8_STAGE(PG8_SA(0, 1), a2 + hstepA, voffA);
            PG8_WAIT_V(8); PG8_WAIT_L(0); PG8_BAR; PG8_MMA(0, 0, At, B0); PG8_MMA(0, 1, At, B1); PG8_BAR; PG8_SCHED;
            PG8_LDA(At, 1, 1); PG8_STAGE(PG8_SB(1, 0), b3, voffB); PG8_STAGE(PG8_SB(1, 1), b3 + hstepB, voffB); PG8_STAGE(PG8_SA(1, 0), a3, voffA);
            PG8_WAIT_V(8); PG8_WAIT_L(0); PG8_BAR; PG8_MMA(1, 0, At, B0); PG8_MMA(1, 1, At, B1); PG8_BAR; PG8_SCHED;
        }
        if constexpr (ALIGN_EPI) { if (wr == 0) PG8_BAR; }
        E(acc, cur, wr, wc, fr, fq);
        if (!has_next) break;
#pragma unroll
        for (int a = 0; a < 2; ++a)
#pragma unroll
            for (int b = 0; b < 2; ++b)
#pragma unroll
                for (int m = 0; m < 4; ++m)
#pragma unroll
                    for (int n = 0; n < 2; ++n) acc[a][b][m][n] = (f32x4){0.f, 0.f, 0.f, 0.f};
        cur = nxt; cA = nA; cB = nB; ++ui;
        if constexpr (ALIGN_EPI) { if (wr == 1) PG8_BAR; }
    }
    PG8_WAIT_V(0);
    if constexpr (!ALIGN_EPI) { if (wr == 0) PG8_BAR; }
    PG8_BAR;
#undef PG8_SA
#undef PG8_SB
#undef PG8_STAGE
#undef PG8_LDA
#undef PG8_LDB
#undef PG8_MMA
#undef PG8_WAIT_V
#undef PG8_WAIT_L
#undef PG8_BAR
#undef PG8_SCHED
}

typedef f32x4 AccT[2][2][4][2];
__device__ __forceinline__ float sigm(float v) { return __builtin_amdgcn_rcpf(1.0f + __builtin_amdgcn_exp2f(-LOG2E * v)); }
__device__ __forceinline__ u32x4 pack8(const f32x4 v0, const f32x4 v1) { u32x4 w; w.x = cvt_pk_bf16(v0[0], v0[1]); w.y = cvt_pk_bf16(v0[2], v0[3]); w.z = cvt_pk_bf16(v1[0], v1[1]); w.w = cvt_pk_bf16(v1[2], v1[3]); return w; }

struct EpiIn {
    static constexpr bool PERM = true;
    bf16_t *PS, *QKVD, *GATES; const float* b_gate; float* SUMSQ;
    __device__ __forceinline__ void operator()(const AccT& acc, const Unit& u, int wr, int wc, int fr, int fq) const {
        const int row0 = u.pm * BM + wr * 64 + fr;
        int kind, ldc, colt; bf16_t* base;
        if (u.pn < 3) { kind = 0; base = PS; ldc = PSW; colt = u.pn * BM; } else if (u.pn < 9) { kind = 1; base = QKVD; ldc = QKVDW; colt = (u.pn - 3) * BM; } else { kind = 2; base = GATES; ldc = GATEW; colt = (u.pn - 9) * BM; }
        const int col0 = colt + wc * 32 + 8 * fq;
        f32x4 bv[2][2];
#pragma unroll
        for (int bj = 0; bj < 2; ++bj)
#pragma unroll
            for (int n = 0; n < 2; ++n) bv[bj][n] = (kind == 2) ? *(const f32x4*)(b_gate + col0 + bj * HALF + 4 * n) : (f32x4){0.f, 0.f, 0.f, 0.f};
#pragma unroll
        for (int ai = 0; ai < 2; ++ai)
#pragma unroll
            for (int m = 0; m < 4; ++m) { const int row = row0 + ai * HALF + m * 16; bf16_t* rowp = base + (size_t)row * ldc + col0;
#pragma unroll
                for (int bj = 0; bj < 2; ++bj) { f32x4 v0 = acc[ai][bj][m][0], v1 = acc[ai][bj][m][1];
                    if (kind == 2) { v0 += bv[bj][0]; v1 += bv[bj][1];
#pragma unroll
                        for (int e = 0; e < 4; ++e) { v0[e] = sigm(v0[e]); v1[e] = sigm(v1[e]); } }
                    *(u32x4*)(rowp + bj * HALF) = pack8(v0, v1);
                    if (kind == 0) {
                        float ss = (v0[0] * v0[0] + v0[1] * v0[1]) + (v0[2] * v0[2] + v0[3] * v0[3]) + (v1[0] * v1[0] + v1[1] * v1[1]) + (v1[2] * v1[2] + v1[3] * v1[3]);
                        ss += __shfl_xor(ss, 16); ss += __shfl_xor(ss, 32);
                        const int t = (u.pn == 0) ? 0 : (u.pn == 1 ? bj : (bj == 0 ? 1 : -1));
                        if (fq == 0 && t >= 0) atomicAdd(SUMSQ + (size_t)row * 2 + t, ss);
                    } } }
    }
};
struct EpiQ {
    static constexpr bool PERM = false;
    bf16_t* Q; const float* SUMSQ; const float* ROPET;
    __device__ __forceinline__ void operator()(const AccT& acc, const Unit& u, int wr, int wc, int fr, int fq) const {
        const int row0 = u.pm * BM + wr * 64 + fr;
#pragma unroll
        for (int ai = 0; ai < 2; ++ai)
#pragma unroll
            for (int m = 0; m < 4; ++m) { const int row = row0 + ai * HALF + m * 16; const int pos = row & (SEQ - 1);
                const float rs = rsqrtf(SUMSQ[(size_t)row * 2] * (1.0f / QLORA) + RMS_EPS) * QSCALE;
#pragma unroll
                for (int bj = 0; bj < 2; ++bj) { const int g32 = u.pn * 8 + bj * 4 + wc; const bool rope = (g32 % 3) == 2;
                    f32x4 v0 = acc[ai][bj][m][0] * rs, v1 = acc[ai][bj][m][1] * rs;
                    if (rope) { const f32x4 c0 = *(const f32x4*)(ROPET + (size_t)(pos * 16 + 4 * fq) * 2), c1 = *(const f32x4*)(ROPET + (size_t)(pos * 16 + 4 * fq) * 2 + 4);
                        const float cs[4] = {c0[0], c0[2], c1[0], c1[2]}, sn[4] = {c0[1], c0[3], c1[1], c1[3]};
                        f32x4 o0, o1;
#pragma unroll
                        for (int e = 0; e < 4; ++e) { o0[e] = v0[e] * cs[e] - v1[e] * sn[e]; o1[e] = v0[e] * sn[e] + v1[e] * cs[e]; }
                        v0 = o0; v1 = o1; }
                    bf16_t* p = Q + (size_t)row * 768 + u.pn * BM + bj * HALF + wc * 32 + 4 * fq;
                    u32x2 w0, w1; w0.x = cvt_pk_bf16(v0[0], v0[1]); w0.y = cvt_pk_bf16(v0[2], v0[3]); w1.x = cvt_pk_bf16(v1[0], v1[1]); w1.y = cvt_pk_bf16(v1[2], v1[3]);
                    *(u32x2*)p = w0; *(u32x2*)(p + 16) = w1; }
                asm volatile("" ::: "memory"); __builtin_amdgcn_sched_barrier(0); }
    }
};
struct EpiKV {
    static constexpr bool PERM = true;
    bf16_t* KV; const float* SUMSQ;
    __device__ __forceinline__ void operator()(const AccT& acc, const Unit& u, int wr, int wc, int fr, int fq) const {
        const int row0 = u.pm * BM + wr * 64 + fr, col0 = u.pn * BM + wc * 32 + 8 * fq;
#pragma unroll
        for (int ai = 0; ai < 2; ++ai)
#pragma unroll
            for (int m = 0; m < 4; ++m) { const int row = row0 + ai * HALF + m * 16;
                const float rs = rsqrtf(SUMSQ[(size_t)row * 2 + 1] * (1.0f / KVLORA) + RMS_EPS);
#pragma unroll
                for (int bj = 0; bj < 2; ++bj) *(u32x4*)(KV + (size_t)row * 1024 + col0 + bj * HALF) = pack8(acc[ai][bj][m][0] * rs, acc[ai][bj][m][1] * rs);
                asm volatile("" ::: "memory"); }
    }
};
struct EpiMix {
    static constexpr bool PERM = true;
    const bf16_t* GATES; bf16_t* T; bf16_t* MIXIN;
    __device__ __forceinline__ void operator()(const AccT& acc, const Unit& u, int wr, int wc, int fr, int fq) const {
        const bool second = u.pm >= 128; const int pm = second ? u.pm - 128 : u.pm, pn = second ? u.pn - 4 : u.pn;
        const int row0 = pm * BM + wr * 64 + fr, col0 = pn * BM + wc * 32 + 8 * fq;
#pragma unroll
        for (int ai = 0; ai < 2; ++ai)
#pragma unroll
            for (int m = 0; m < 4; ++m) { const int row = row0 + ai * HALF + m * 16;
#pragma unroll
                for (int bj = 0; bj < 2; ++bj) { const int col = col0 + bj * HALF;
                    const u32x4 g = *(const u32x4*)(GATES + (size_t)row * GATEW + (second ? 1024 : 0) + col);
                    f32x4 v0 = acc[ai][bj][m][0], v1 = acc[ai][bj][m][1];
                    v0[0] *= lo16(g.x); v0[1] *= hi16(g.x); v0[2] *= lo16(g.y); v0[3] *= hi16(g.y); v1[0] *= lo16(g.z); v1[1] *= hi16(g.z); v1[2] *= lo16(g.w); v1[3] *= hi16(g.w);
                    if (second) { const u32x4 t = *(const u32x4*)(T + (size_t)row * 1024 + col);
                        v0[0] += lo16(t.x); v0[1] += hi16(t.x); v0[2] += lo16(t.y); v0[3] += hi16(t.y); v1[0] += lo16(t.z); v1[1] += hi16(t.z); v1[2] += lo16(t.w); v1[3] += hi16(t.w);
                        *(u32x4*)(MIXIN + (size_t)row * 1024 + col) = pack8(v0, v1); }
                    else *(u32x4*)(T + (size_t)row * 1024 + col) = pack8(v0, v1); } }
    }
};
struct EpiRes {
    static constexpr bool PERM = false;
    const float* base; float* out;
    __device__ __forceinline__ void operator()(const AccT& acc, const Unit& u, int wr, int wc, int fr, int fq) const {
        const int row0 = u.pm * BM + wr * 64 + fr, col0 = u.pn * BM + wc * 32 + 4 * fq;
#pragma unroll
        for (int ai = 0; ai < 2; ++ai)
#pragma unroll
            for (int m = 0; m < 4; ++m) { const size_t off = (size_t)(row0 + ai * HALF + m * 16) * DM + col0;
#pragma unroll
                for (int bj = 0; bj < 2; ++bj)
#pragma unroll
                    for (int n = 0; n < 2; ++n) { const f32x4 bs = *(const f32x4*)(base + off + bj * HALF + n * 16); *(f32x4*)(out + off + bj * HALF + n * 16) = bs * ALPHA + acc[ai][bj][m][n]; } }
    }
};
struct EpiSqRelu {
    static constexpr bool PERM = true;
    bf16_t* H;
    __device__ __forceinline__ void operator()(const AccT& acc, const Unit& u, int wr, int wc, int fr, int fq) const {
        const int row0 = u.pm * BM + wr * 64 + fr, col0 = u.pn * BM + wc * 32 + 8 * fq;
#pragma unroll
        for (int ai = 0; ai < 2; ++ai)
#pragma unroll
            for (int m = 0; m < 4; ++m) { bf16_t* rowp = H + (size_t)(row0 + ai * HALF + m * 16) * DFF + col0;
#pragma unroll
                for (int bj = 0; bj < 2; ++bj) { f32x4 v0 = acc[ai][bj][m][0], v1 = acc[ai][bj][m][1];
#pragma unroll
                    for (int e = 0; e < 4; ++e) { const float a = fmaxf(v0[e], 0.f), b = fmaxf(v1[e], 0.f); v0[e] = a * a; v1[e] = b * b; }
                    *(u32x4*)(rowp + bj * HALF) = pack8(v0, v1); } }
    }
};
}

namespace fa {
typedef short bf16x8 __attribute__((ext_vector_type(8)));
typedef short s16x4 __attribute__((ext_vector_type(4)));
typedef short v4i16_t __attribute__((ext_vector_type(4)));
typedef float f32x16 __attribute__((ext_vector_type(16)));
constexpr int VBUF = 4096;
__device__ __forceinline__ s16x4 vtr(LAS const unsigned char* p) { return __builtin_bit_cast(s16x4, __builtin_amdgcn_ds_read_tr16_b64_v4i16((LAS v4i16_t*)p)); }
__device__ __forceinline__ unsigned cvtpk(float lo, float hi) { unsigned r; asm volatile("v_cvt_pk_bf16_f32 %0, %1, %2" : "=v"(r) : "v"(lo), "v"(hi)); return r; }
struct State { f32x16 o0, o1; float m, l; };
__device__ __forceinline__ void st_init(State& st) { st.o0 = f32x16{}; st.o1 = f32x16{}; st.m = -1e30f; st.l = 0.f; }
__device__ __forceinline__ void v_store(LAS unsigned char* vb, const u32x4 (&vr)[4], int lane) {
#pragma unroll
    for (int i = 0; i < 4; ++i) { const int key = (i * 64 + lane) >> 3, c = lane & 7; *(LAS u32x4*)(vb + (c >> 2) * 2048 + key * 64 + (c & 3) * 16) = vr[i]; }
}
__device__ __forceinline__ void softmax_pv(State& st, f32x16& t, LAS const unsigned char* vb, int lane) {
    float mx = fmaxf(fmaxf(t[0], t[1]), fmaxf(t[2], t[3]));
#pragma unroll
    for (int r = 4; r < 16; r += 4) mx = fmaxf(mx, fmaxf(fmaxf(t[r], t[r + 1]), fmaxf(t[r + 2], t[r + 3])));
    mx = fmaxf(mx, __shfl_xor(mx, 32));
    const float mn = fmaxf(st.m, mx);
    if (__any(mn > st.m)) { const float sc = __builtin_amdgcn_exp2f(st.m - mn); st.l *= sc; st.o0 *= sc; st.o1 *= sc; st.m = mn; }
    float sum = 0.f;
#pragma unroll
    for (int r = 0; r < 16; ++r) { t[r] = __builtin_amdgcn_exp2f(t[r] - mn); sum += t[r]; }
    st.l += sum;
    u32x4 w0, w1;
    w0.x = cvtpk(t[0], t[1]); w0.y = cvtpk(t[2], t[3]); w0.z = cvtpk(t[4], t[5]); w0.w = cvtpk(t[6], t[7]);
    w1.x = cvtpk(t[8], t[9]); w1.y = cvtpk(t[10], t[11]); w1.z = cvtpk(t[12], t[13]); w1.w = cvtpk(t[14], t[15]);
    const bf16x8 pf0 = __builtin_bit_cast(bf16x8, w0), pf1 = __builtin_bit_cast(bf16x8, w1);
    LAS const unsigned char* vp = vb + (4 * (lane >> 5) + ((lane & 15) >> 2)) * 64 + (16 * ((lane >> 4) & 1) + 4 * (lane & 3)) * 2;
#define FA_VF(d0, s) ([&]() { const s16x4 a = vtr(vp + (d0) * 2048 + (s) * 1024), b = vtr(vp + (d0) * 2048 + (s) * 1024 + 512); return (bf16x8){a[0], a[1], a[2], a[3], b[0], b[1], b[2], b[3]}; }())
    const bf16x8 v00 = FA_VF(0, 0), v01 = FA_VF(0, 1), v10 = FA_VF(1, 0), v11 = FA_VF(1, 1);
#undef FA_VF
    st.o0 = __builtin_amdgcn_mfma_f32_32x32x16_bf16(v00, pf0, st.o0, 0, 0, 0);
    st.o1 = __builtin_amdgcn_mfma_f32_32x32x16_bf16(v10, pf0, st.o1, 0, 0, 0);
    st.o0 = __builtin_amdgcn_mfma_f32_32x32x16_bf16(v01, pf1, st.o0, 0, 0, 0);
    st.o1 = __builtin_amdgcn_mfma_f32_32x32x16_bf16(v11, pf1, st.o1, 0, 0, 0);
}
__device__ __forceinline__ void o_store(State& st, bf16_t* orow, int lane) {
    const float lt = st.l + __shfl_xor(st.l, 32); const float il = 1.0f / lt; const int hi = lane >> 5;
#pragma unroll
    for (int rr = 0; rr < 4; ++rr) {
        u32x2 a, b; a.x = cvtpk(st.o0[4 * rr] * il, st.o0[4 * rr + 1] * il); a.y = cvtpk(st.o0[4 * rr + 2] * il, st.o0[4 * rr + 3] * il);
        b.x = cvtpk(st.o1[4 * rr] * il, st.o1[4 * rr + 1] * il); b.y = cvtpk(st.o1[4 * rr + 2] * il, st.o1[4 * rr + 3] * il);
        *(u32x2*)(orow + 8 * rr + 4 * hi) = a; *(u32x2*)(orow + 32 + 8 * rr + 4 * hi) = b;
    }
}
__device__ __forceinline__ void mla_item(const bf16_t* Q, const bf16_t* KV, const bf16_t* KR, bf16_t* O, int b, int h, int qt, LAS unsigned char* vl, int lane) {
    const int r32 = lane & 31, hi = lane >> 5;
    const size_t mq = (size_t)b * SEQ + 32 * qt + r32;
    bf16x8 qf[6];
#pragma unroll
    for (int ds = 0; ds < 6; ++ds) qf[ds] = *(const bf16x8*)(Q + mq * 768 + h * 96 + 16 * ds + 8 * hi);
    State st; st_init(st);
    bf16x8 kn[6]; u32x4 vr[4];
#define MLA_LOAD(kt) do { const size_t mk_ = (size_t)b * SEQ + 32 * (kt) + r32; \
        _Pragma("unroll") for (int ds = 0; ds < 4; ++ds) kn[ds] = *(const bf16x8*)(KV + mk_ * 1024 + h * 128 + 16 * ds + 8 * hi); \
        _Pragma("unroll") for (int e = 0; e < 2; ++e) kn[4 + e] = *(const bf16x8*)(KR + mk_ * 32 + 16 * e + 8 * hi); \
        _Pragma("unroll") for (int i = 0; i < 4; ++i) vr[i] = *(const u32x4*)(KV + ((size_t)b * SEQ + 32 * (kt) + ((i * 64 + lane) >> 3)) * 1024 + h * 128 + 64 + (lane & 7) * 8); } while (0)
    MLA_LOAD(0);
    v_store(vl, vr, lane);
    for (int kt = 0; kt <= qt; ++kt) {
        bf16x8 kf[6];
#pragma unroll
        for (int ds = 0; ds < 6; ++ds) kf[ds] = kn[ds];
        if (kt < qt) MLA_LOAD(kt + 1);
        f32x16 s = f32x16{};
#pragma unroll
        for (int ds = 0; ds < 6; ++ds) s = __builtin_amdgcn_mfma_f32_32x32x16_bf16(kf[ds], qf[ds], s, 0, 0, 0);
        if (kt == qt) {
#pragma unroll
            for (int r = 0; r < 16; ++r) { const int key = (r & 3) + 8 * (r >> 2) + 4 * hi; if (key > r32) s[r] = -INFINITY; }
        }
        asm volatile("" ::: "memory");
        softmax_pv(st, s, vl + (kt & 1) * VBUF, lane);
        asm volatile("" ::: "memory");
        if (kt < qt) v_store(vl + ((kt + 1) & 1) * VBUF, vr, lane);
    }
#undef MLA_LOAD
    o_store(st, O + mq * 512 + h * 64, lane);
}
__device__ __forceinline__ void dil_item(const bf16_t* QKVD, bf16_t* O, int b, int h, int r, int pb, LAS unsigned char* vl, int lane) {
    const int r32 = lane & 31, hi = lane >> 5;
    const size_t mq = (size_t)b * SEQ + 4 * (32 * pb + r32) + r;
    bf16x8 qf[4];
#pragma unroll
    for (int ds = 0; ds < 4; ++ds) qf[ds] = *(const bf16x8*)(QKVD + mq * QKVDW + h * 64 + 16 * ds + 8 * hi);
    const float slope2 = __builtin_amdgcn_exp2f(-(float)(h + 1)) * LOG2E;
    constexpr float C1 = 0.125f * LOG2E;
    State st; st_init(st);
    const int nt = (pb + 1) + (pb >= 1 ? 6 : 3);
    bf16x8 kn[4]; u32x4 vr[4];
#define DIL_TILE(t, rho, kb) do { if ((t) <= pb) { rho = r; kb = (t); } else { const int u_ = (t) - (pb + 1); if (pb >= 1) { rho = (r + 1 + (u_ >> 1)) & 3; kb = pb - 1 + (u_ & 1); } else { rho = (r + 1 + u_) & 3; kb = 0; } } } while (0)
#define DIL_LOAD(rho, kb) do { const size_t mk_ = (size_t)b * SEQ + 4 * (32 * (kb) + r32) + (rho); \
        _Pragma("unroll") for (int ds = 0; ds < 4; ++ds) kn[ds] = *(const bf16x8*)(QKVD + mk_ * QKVDW + 512 + h * 64 + 16 * ds + 8 * hi); \
        _Pragma("unroll") for (int i = 0; i < 4; ++i) vr[i] = *(const u32x4*)(QKVD + ((size_t)b * SEQ + 4 * (32 * (kb) + ((i * 64 + lane) >> 3)) + (rho)) * QKVDW + 1024 + h * 64 + (lane & 7) * 8); } while (0)
    int rho, kb; DIL_TILE(0, rho, kb);
    DIL_LOAD(rho, kb);
    v_store(vl, vr, lane);
    for (int t = 0; t < nt; ++t) {
        bf16x8 kf[4];
#pragma unroll
        for (int ds = 0; ds < 4; ++ds) kf[ds] = kn[ds];
        const int dbase = 128 * (pb - kb) + (r - rho);
        int rho2 = 0, kb2 = 0;
        if (t + 1 < nt) { DIL_TILE(t + 1, rho2, kb2); DIL_LOAD(rho2, kb2); }
        f32x16 s = f32x16{};
#pragma unroll
        for (int ds = 0; ds < 4; ++ds) s = __builtin_amdgcn_mfma_f32_32x32x16_bf16(kf[ds], qf[ds], s, 0, 0, 0);
        const int dl = dbase + 4 * r32 - 16 * hi;
#pragma unroll
        for (int rg = 0; rg < 16; ++rg) {
            const int d = dl - 4 * ((rg & 3) + 8 * (rg >> 2));
            const int w = (d <= 128 ? 1 : 0) + (((d & 3) == 0 && d <= 512) ? 1 : 0) + ((d & 15) == 0 ? 1 : 0);
            const float lw = (d < 0 || w == 0) ? -INFINITY : (w == 1 ? 0.f : (w == 2 ? 1.f : 1.5849625007f));
            s[rg] = s[rg] * C1 - slope2 * (float)d + lw;
        }
        asm volatile("" ::: "memory");
        softmax_pv(st, s, vl + (t & 1) * VBUF, lane);
        asm volatile("" ::: "memory");
        if (t + 1 < nt) v_store(vl + ((t + 1) & 1) * VBUF, vr, lane);
        rho = rho2; kb = kb2;
    }
#undef DIL_TILE
#undef DIL_LOAD
    o_store(st, O + ((size_t)M + mq) * 512 + h * 64, lane);
}
}
__device__ __forceinline__ void p3_fast_mla_only(Ctx& C, LAS unsigned char* lds) {
    LAS unsigned char* vl = lds + C.wave * (2 * fa::VBUF);
    for (int pid = C.gw; pid < BATCH * NH * 32; pid += C.ngw) {
        const int bh = pid >> 5, sidx = pid & 31;
        fa::mla_item(C.Q, C.KV, C.KR, C.OAB, bh >> 3, bh & 7, 63 - sidx, vl, C.lane);
        fa::mla_item(C.Q, C.KV, C.KR, C.OAB, bh >> 3, bh & 7, sidx, vl, C.lane);
    }
}
__device__ __forceinline__ void p3_fast_dil_only(Ctx& C, LAS unsigned char* lds) {
    LAS unsigned char* vl = lds + C.wave * (2 * fa::VBUF);
    for (int pid = C.gw; pid < BATCH * NH * 32; pid += C.ngw) {
        const int bh = pid >> 5, r = (pid >> 3) & 3, sidx = pid & 7;
        fa::dil_item(C.QKVD, C.OAB, bh >> 3, bh & 7, r, 15 - sidx, vl, C.lane);
        fa::dil_item(C.QKVD, C.OAB, bh >> 3, bh & 7, r, sidx, vl, C.lane);
    }
}
__device__ __forceinline__ void p3_fast(Ctx& C, LAS unsigned char* lds) {
    LAS unsigned char* vl = lds + C.wave * (2 * fa::VBUF);
    for (int pid = C.gw; pid < BATCH * NH * 32; pid += C.ngw) {
        const int bh = pid >> 5, sidx = pid & 31;
        fa::mla_item(C.Q, C.KV, C.KR, C.OAB, bh >> 3, bh & 7, 63 - sidx, vl, C.lane);
        fa::mla_item(C.Q, C.KV, C.KR, C.OAB, bh >> 3, bh & 7, sidx, vl, C.lane);
    }
    for (int pid = C.gw; pid < BATCH * NH * 32; pid += C.ngw) {
        const int bh = pid >> 5, r = (pid >> 3) & 3, sidx = pid & 7;
        fa::dil_item(C.QKVD, C.OAB, bh >> 3, bh & 7, r, 15 - sidx, vl, C.lane);
        fa::dil_item(C.QKVD, C.OAB, bh >> 3, bh & 7, r, sidx, vl, C.lane);
    }
}

#ifndef F_IN
#define F_IN 1
#endif
#ifndef F_UP
#define F_UP 1
#endif
#ifndef F_MIX
#define F_MIX 1
#endif
#ifndef F_OUT
#define F_OUT 1
#endif
#ifndef F_FF1
#define F_FF1 1
#endif
#ifndef F_FF2
#define F_FF2 1
#endif
#ifndef F_ATTN
#define F_ATTN 1
#endif
__device__ __forceinline__ void kr_rope(Ctx& C) {
    for (long idx = C.gt; idx < (long)M * 16; idx += C.ngt) {
        const int m = (int)(idx >> 4), j = (int)(idx & 15), pos = m % SEQ;
        const float c = C.ROPET[2 * (pos * 16 + j)], s = C.ROPET[2 * (pos * 16 + j) + 1];
        const float t1 = bf2f(C.PS[(size_t)m * PSW + 640 + j]), t2 = bf2f(C.PS[(size_t)m * PSW + 656 + j]);
        C.KR[(size_t)m * 32 + j] = (bf16_t)f2bf(t1 * c - t2 * s); C.KR[(size_t)m * 32 + 16 + j] = (bf16_t)f2bf(t1 * s + t2 * c);
    }
}

constexpr int NTHREADS = 512;
constexpr int LDS_BYTES = 147456;
constexpr int NPHASES = 12;

__global__ void __launch_bounds__(NTHREADS, 2) fwd_megakernel(Args args) {
    extern __shared__ __attribute__((aligned(16))) unsigned char lds_raw[];
    LAS unsigned char* lds = (LAS unsigned char*)lds_raw;
    cg::grid_group grid = cg::this_grid();
    Ctx C;
    C.tid = threadIdx.x; C.lane = C.tid & 63; C.wave = __builtin_amdgcn_readfirstlane(C.tid >> 6);
    C.gw = blockIdx.x * (NTHREADS / 64) + C.wave; C.ngw = gridDim.x * (NTHREADS / 64);
    C.gt = (long)blockIdx.x * NTHREADS + C.tid; C.ngt = (long)gridDim.x * NTHREADS;
    C.x = args.in[0]; C.w_in = args.in[1]; C.b_gate = args.in[2]; C.g_q_a = args.in[3]; C.w_uq = args.in[4]; C.g_kv_a = args.in[5]; C.w_ukv = args.in[6];
    C.w_o_mla = args.in[7]; C.w_o_dil = args.in[8]; C.w_out = args.in[9]; C.ln1_g = args.in[10]; C.ln1_b = args.in[11]; C.w_ff1 = args.in[12]; C.w_ff2 = args.in[13];
    C.ln2_g = args.in[14]; C.ln2_b = args.in[15]; C.out = args.out; C.ws = args.ws;
    unsigned char* ws = args.ws;
    C.WIN = (bf16_t*)(ws + WS_WIN); C.WUQ = (bf16_t*)(ws + WS_WUQ); C.WUKV = (bf16_t*)(ws + WS_WUKV); C.WOAB = (bf16_t*)(ws + WS_WOAB); C.WOUT = (bf16_t*)(ws + WS_WOUT);
    C.WFF1 = (bf16_t*)(ws + WS_WFF1); C.WFF2 = (bf16_t*)(ws + WS_WFF2); C.ROPET = (float*)(ws + WS_ROPE); C.SUMSQ = (float*)(ws + WS_SUMSQ);
    C.PS = (bf16_t*)(ws + WS_PS); C.QKVD = (bf16_t*)(ws + WS_QKVD); C.GATES = (bf16_t*)(ws + WS_GATES); C.XB = (bf16_t*)(ws + WS_XB); C.Q = C.XB; C.MIXIN = C.XB;
    C.KV = (bf16_t*)(ws + WS_KV); C.T = C.KV; C.HB = C.KV; C.OAB = (bf16_t*)(ws + WS_OAB); C.KR = (bf16_t*)(ws + WS_KR); C.HID = (bf16_t*)(ws + WS_HID);

    const int G = gridDim.x, cu = blockIdx.x;
#define SYNC() grid.sync()
    p0_prologue(C, lds); SYNC();
#if F_IN
    { pg8::Gemm g{C.XB, C.WIN, DM, DM, DM}; pg8::StaticOrder S; S.init(M, NIN, G, cu);
      pg8::EpiIn E{C.PS, C.QKVD, C.GATES, C.b_gate, C.SUMSQ};
      pg8::gemm_phase<pg8::EpiIn, pg8::StaticOrder, true>(lds, g, S, E); }
    SYNC();
#else
    p1_naive(C); SYNC();
#endif
#if F_UP
#ifndef T_NOQ
    { pg8::Gemm g{C.PS, C.WUQ, QLORA, PSW, QLORA}; pg8::StaticOrder S; S.init(M, 768, G, cu);
      pg8::EpiQ E{C.Q, C.SUMSQ, C.ROPET};
      pg8::gemm_phase<pg8::EpiQ, pg8::StaticOrder, true>(lds, g, S, E); }
#endif
#ifndef T_NOKV
    { pg8::Gemm g{C.PS + QLORA, C.WUKV, KVLORA, PSW, KVLORA}; pg8::StaticOrder S; S.init(M, 1024, G, cu);
      pg8::EpiKV E{C.KV, C.SUMSQ};
      pg8::gemm_phase<pg8::EpiKV, pg8::StaticOrder, true>(lds, g, S, E); }
#endif
    kr_rope(C);
    SYNC();
#else
    p2_naive(C); SYNC();
    p2b_naive_qrope(C); SYNC();
#endif
#if F_ATTN == 1
    p3_fast(C, lds);
#elif F_ATTN == 2
    p3_naive_mla(C); p3_fast_dil_only(C, lds);
#elif F_ATTN == 3
    p3_fast_mla_only(C, lds); p3_naive_dil(C);
#else
    p3_naive_mla(C); p3_naive_dil(C);
#endif
    SYNC();
#if F_MIX
    { pg8::Gemm g{C.OAB, C.WOAB, 512, 512, 512}; pg8::PairOrder S; S.init(M, 1024, G, cu);
      pg8::EpiMix E{C.GATES, C.T, C.MIXIN};
      pg8::gemm_phase<pg8::EpiMix, pg8::PairOrder, true>(lds, g, S, E); }
    SYNC();
#else
    p4_naive(C); SYNC();
    p4b_naive(C); SYNC();
#endif
#if F_OUT
    { pg8::Gemm g{C.MIXIN, C.WOUT, DM, DM, DM}; pg8::StaticOrder S; S.init(M, DM, G, cu);
      pg8::EpiRes E{C.x, C.out};
      pg8::gemm_phase<pg8::EpiRes, pg8::StaticOrder, true>(lds, g, S, E); }
    SYNC();
#else
    p5_naive(C); SYNC();
#endif
    ln_rows(C, C.ln1_g, C.ln1_b, C.HB); SYNC();
#if F_FF1
    { pg8::Gemm g{C.HB, C.WFF1, DM, DM, DM}; pg8::StaticOrder S; S.init(M, DFF, G, cu);
      pg8::EpiSqRelu E{C.HID};
      pg8::gemm_phase<pg8::EpiSqRelu, pg8::StaticOrder, true>(lds, g, S, E); }
    SYNC();
#else
    p7_naive(C); SYNC();
#endif
#if F_FF2
    { pg8::Gemm g{C.HID, C.WFF2, DFF, DFF, DFF}; pg8::StaticOrder S; S.init(M, DM, G, cu);
      pg8::EpiRes E{C.out, C.out};
      pg8::gemm_phase<pg8::EpiRes, pg8::StaticOrder, true>(lds, g, S, E); }
    SYNC();
#else
    p8_naive(C); SYNC();
#endif
    ln_rows(C, C.ln2_g, C.ln2_b, nullptr);
#undef SYNC
}

extern "C" void kernel_launch(void* const* d_in, const int* in_sizes, int n_in, void* d_out, int out_size, void* d_ws, size_t ws_size, hipStream_t stream) {
    static int grid = 0;
    if (grid == 0) {
        if (n_in != 16 || in_sizes[0] != M * DM || out_size != M * DM || ws_size < WS_END) {
            fprintf(stderr, "kernel_launch: unexpected shapes: n_in %d in0 %d out %d ws %zu (need >= %zu)\n", n_in, n_in > 0 ? in_sizes[0] : -1, out_size, ws_size, (size_t)WS_END);
            grid = -1; return;
        }
        int dev = 0, cus = 0, per_cu = 0;
        (void)hipGetDevice(&dev);
        (void)hipDeviceGetAttribute(&cus, hipDeviceAttributeMultiprocessorCount, dev);
        (void)hipFuncSetAttribute((const void*)fwd_megakernel, hipFuncAttributeMaxDynamicSharedMemorySize, LDS_BYTES);
        (void)hipOccupancyMaxActiveBlocksPerMultiprocessor(&per_cu, (const void*)fwd_megakernel, NTHREADS, LDS_BYTES);
        if (per_cu < 1) { fprintf(stderr, "kernel_launch: occupancy query returned %d\n", per_cu); per_cu = 1; }
        (void)hipGetLastError();
        grid = cus * per_cu;
    }
    if (grid < 0) return;
    Args a{};
    for (int i = 0; i < 16; ++i) a.in[i] = (const float*)d_in[i];
    a.out = (float*)d_out; a.ws = (unsigned char*)d_ws; a.ph_lo = 0; a.ph_hi = NPHASES;
    void* kargs[] = {&a};
    hipError_t e = hipLaunchCooperativeKernel((const void*)fwd_megakernel, dim3(grid), dim3(NTHREADS), kargs, LDS_BYTES, stream);
    if (e != hipSuccess) fprintf(stderr, "cooperative launch failed: %s (grid %d)\n", hipGetErrorString(e), grid);
}
```

```cpp
#include <hip/hip_runtime.h>
#include <hip/hip_cooperative_groups.h>
#include <cstdio>
#include <cstdint>
namespace cg = cooperative_groups;

#define LAS __attribute__((address_space(3)))
typedef unsigned short bf16_t;
typedef float f32x4 __attribute__((ext_vector_type(4)));
typedef unsigned u32x4 __attribute__((ext_vector_type(4)));
typedef unsigned u32x2 __attribute__((ext_vector_type(2)));

constexpr int BATCH = 16, SEQ = 2048, DM = 1024, M = BATCH * SEQ;
constexpr int NH = 8;
constexpr int QLORA = 384, KVLORA = 256, ROPE = 32, NOPE = 64, VD = 64, QK = 96;
constexpr int NIN = 4352;
constexpr int PSW = 768, QKVDW = 1536, GATEW = 2048;
constexpr int DFF = 4096;
constexpr float LN_EPS = 1e-5f, RMS_EPS = 1e-6f;
constexpr float ALPHA = 1.189207115002721f;
constexpr float LOG2E = 1.4426950408889634f;
constexpr float QSCALE = 0.10206207261596577f * LOG2E;

constexpr size_t MiB = 1u << 20;
constexpr size_t WS_WIN = 2 * MiB;
constexpr size_t WS_WUQ = 11 * MiB;
constexpr size_t WS_WUKV = 12 * MiB;
constexpr size_t WS_WOAB = 13 * MiB;
constexpr size_t WS_WOUT = 15 * MiB;
constexpr size_t WS_WFF1 = 17 * MiB;
constexpr size_t WS_WFF2 = 25 * MiB;
constexpr size_t WS_ROPE = 33 * MiB;
constexpr size_t WS_SUMSQ = 33 * MiB + 512 * 1024;
constexpr size_t WS_PS = 34 * MiB;
constexpr size_t WS_QKVD = 82 * MiB;
constexpr size_t WS_GATES = 178 * MiB;
constexpr size_t WS_XB = 306 * MiB;
constexpr size_t WS_KV = 370 * MiB;
constexpr size_t WS_OAB = 434 * MiB;
constexpr size_t WS_KR = 498 * MiB;
constexpr size_t WS_HID = 34 * MiB;
constexpr size_t WS_END = 500 * MiB;

__device__ __forceinline__ float bf2f(bf16_t v) { return __uint_as_float((unsigned)v << 16); }
__device__ __forceinline__ unsigned f2bf(float f) { unsigned u = __float_as_uint(f); return (u + 0x7fffu + ((u >> 16) & 1u)) >> 16; }
__device__ __forceinline__ unsigned pk2(float lo, float hi) { return f2bf(lo) | (f2bf(hi) << 16); }
__device__ __forceinline__ float lo16(unsigned u) { return __uint_as_float(u << 16); }
__device__ __forceinline__ float hi16(unsigned u) { return __uint_as_float(u & 0xffff0000u); }
__device__ __forceinline__ float wave_sum(float v) {
#pragma unroll
    for (int o = 1; o < 64; o <<= 1) v += __shfl_xor(v, o);
    return v;
}

struct Args { const float* in[16]; float* out; unsigned char* ws; int ph_lo, ph_hi; };

__device__ __forceinline__ int lane_id() { int t = threadIdx.x; asm volatile("" : "+v"(t)); return t & 63; }
__device__ __forceinline__ long gt_id() { return (long)blockIdx.x * 512 + threadIdx.x; }
struct Ctx {
    int wave, gw, ngw; long ngt;
    const float *x, *w_in, *b_gate, *g_q_a, *w_uq, *g_kv_a, *w_ukv, *w_o_mla, *w_o_dil, *w_out, *ln1_g, *ln1_b, *w_ff1, *w_ff2, *ln2_g, *ln2_b;
    float* out; unsigned char* ws;
    bf16_t *WIN, *WUQ, *WUKV, *WOAB, *WOUT, *WFF1, *WFF2, *PS, *QKVD, *GATES, *XB, *Q, *MIXIN, *KV, *T, *HB, *OAB, *KR, *HID;
    float* ROPET; float* SUMSQ;
};

__device__ __forceinline__ void transpose_item(const float* W, int Nsrc, int src_n0, const float* kscale, bf16_t* WT, int K, int dst_n0, int k0, LAS float* scr, int lane) {
#pragma unroll 8
    for (int i = 0; i < 32; ++i) {
        const int kk = 2 * i + (lane >> 5);
        float v = 0.f;
        if (src_n0 >= 0) { v = W[(size_t)(k0 + kk) * Nsrc + src_n0 + (lane & 31)]; if (kscale) v *= kscale[k0 + kk]; }
        scr[kk * 33 + (lane & 31)] = v;
    }
    asm volatile("s_waitcnt lgkmcnt(0)" ::: "memory");
    const int c = lane & 7;
#pragma unroll
    for (int j = 0; j < 4; ++j) {
        const int n = (lane >> 3) + 8 * j; const LAS float* s = scr + (8 * c) * 33 + n;
        u32x4 o; o.x = pk2(s[0 * 33], s[1 * 33]); o.y = pk2(s[2 * 33], s[3 * 33]); o.z = pk2(s[4 * 33], s[5 * 33]); o.w = pk2(s[6 * 33], s[7 * 33]);
        *(u32x4*)(WT + (size_t)(dst_n0 + n) * K + k0 + 8 * c) = o;
    }
    asm volatile("s_waitcnt lgkmcnt(0)" ::: "memory");
}
__device__ __forceinline__ bool tr_matrix(int& r, const float* W, int K, int Nsrc, int Ndst, bool in_map, const float* kscale, bf16_t* WT, int dst_row_off, LAS float* scr, int lane) {
    const int nblk = Ndst / 32, items = (K / 64) * nblk;
    if (r >= items) { r -= items; return false; }
    const int kb = r / nblk, nb = r % nblk, n0 = nb * 32;
    int src = n0;
    if (in_map) src = (n0 < 672) ? n0 : (n0 < 768 ? -1 : n0 - 96);
    transpose_item(W, Nsrc, src, kscale, WT, K, dst_row_off + n0, kb * 64, scr, lane);
    return true;
}
__device__ __forceinline__ void p0_prologue(Ctx& C, LAS unsigned char* lds) {
    LAS float* scr = (LAS float*)(lds + C.wave * 16384);
    constexpr int NITEMS = 16 * 136 + 6 * 24 + 4 * 32 + 8 * 32 + 8 * 32 + 16 * 32 + 16 * 128 + 64 * 32;
    for (int it = C.gw; it < NITEMS; it += C.ngw) {
        int r = it;
        if (tr_matrix(r, C.w_in, 1024, 4256, NIN, true, nullptr, C.WIN, 0, scr, lane_id())) continue;
        if (tr_matrix(r, C.w_uq, QLORA, 768, 768, false, C.g_q_a, C.WUQ, 0, scr, lane_id())) continue;
        if (tr_matrix(r, C.w_ukv, KVLORA, 1024, 1024, false, C.g_kv_a, C.WUKV, 0, scr, lane_id())) continue;
        if (tr_matrix(r, C.w_o_mla, 512, 1024, 1024, false, nullptr, C.WOAB, 0, scr, lane_id())) continue;
        if (tr_matrix(r, C.w_o_dil, 512, 1024, 1024, false, nullptr, C.WOAB, 1024, scr, lane_id())) continue;
        if (tr_matrix(r, C.w_out, 1024, 1024, 1024, false, nullptr, C.WOUT, 0, scr, lane_id())) continue;
        if (tr_matrix(r, C.w_ff1, 1024, 4096, 4096, false, nullptr, C.WFF1, 0, scr, lane_id())) continue;
        tr_matrix(r, C.w_ff2, 4096, 1024, 1024, false, nullptr, C.WFF2, 0, scr, lane_id());
    }
    {
        const f32x4* xs = (const f32x4*)C.x; u32x2* xd = (u32x2*)C.XB; const long n4 = (long)M * DM / 4;
        for (long i = gt_id(); i < n4; i += C.ngt) { const f32x4 v = xs[i]; u32x2 o; o.x = pk2(v.x, v.y); o.y = pk2(v.z, v.w); xd[i] = o; }
    }
    for (long i = gt_id(); i < SEQ * 16; i += C.ngt) {
        const int pos = (int)(i >> 4), j = (int)(i & 15);
        const float inv = powf(10000.0f, -(float)j / 16.0f); const float ang = (float)pos * inv;
        C.ROPET[2 * i] = cosf(ang); C.ROPET[2 * i + 1] = sinf(ang);
    }
    for (long i = gt_id(); i < (long)M * 2; i += C.ngt) C.SUMSQ[i] = 0.f;
}

template <class F> __device__ __forceinline__ void naive_gemm(Ctx& C, const bf16_t* A, int lda, const bf16_t* Bt, int ldb, int Mr, int N, int K, F epi) {
    const int n4 = N / 4; const long total = (long)Mr * n4;
    for (long idx = gt_id(); idx < total; idx += C.ngt) {
        const int m = (int)(idx / n4), n0 = (int)(idx % n4) * 4;
        float a0 = 0.f, a1 = 0.f, a2 = 0.f, a3 = 0.f, ss = 0.f;
        const bf16_t* ar = A + (size_t)m * lda; const bf16_t* br = Bt + (size_t)n0 * ldb;
        for (int k = 0; k < K; k += 8) {
            const u32x4 av = *(const u32x4*)(ar + k);
            const u32x4 b0 = *(const u32x4*)(br + k), b1 = *(const u32x4*)(br + ldb + k), b2 = *(const u32x4*)(br + 2 * ldb + k), b3 = *(const u32x4*)(br + 3 * ldb + k);
#pragma unroll
            for (int e = 0; e < 4; ++e) {
                const float al = lo16(av[e]), ah = hi16(av[e]);
                ss += al * al + ah * ah;
                a0 += al * lo16(b0[e]) + ah * hi16(b0[e]); a1 += al * lo16(b1[e]) + ah * hi16(b1[e]);
                a2 += al * lo16(b2[e]) + ah * hi16(b2[e]); a3 += al * lo16(b3[e]) + ah * hi16(b3[e]);
            }
        }
        epi(m, n0, a0, a1, a2, a3, ss);
    }
}
__device__ __forceinline__ float sigmoidf_(float v) { return 1.0f / (1.0f + __expf(-v)); }

__device__ __forceinline__ void p1_naive(Ctx& C) {
    naive_gemm(C, C.XB, DM, C.WIN, DM, M, NIN, DM, [&](int m, int n0, float a0, float a1, float a2, float a3, float) {
        u32x2 o;
        if (n0 < PSW) { o.x = pk2(a0, a1); o.y = pk2(a2, a3); *(u32x2*)(C.PS + (size_t)m * PSW + n0) = o; }
        else if (n0 < PSW + QKVDW) { o.x = pk2(a0, a1); o.y = pk2(a2, a3); *(u32x2*)(C.QKVD + (size_t)m * QKVDW + (n0 - PSW)) = o; }
        else { const int g = n0 - PSW - QKVDW; const f32x4 b = *(const f32x4*)(C.b_gate + g);
            o.x = pk2(sigmoidf_(a0 + b.x), sigmoidf_(a1 + b.y)); o.y = pk2(sigmoidf_(a2 + b.z), sigmoidf_(a3 + b.w)); *(u32x2*)(C.GATES + (size_t)m * GATEW + g) = o; }
    });
}
__device__ __forceinline__ void p2_naive(Ctx& C) {
    naive_gemm(C, C.PS, PSW, C.WUQ, QLORA, M, 768, QLORA, [&](int m, int n0, float a0, float a1, float a2, float a3, float ss) {
        const float rs = rsqrtf(ss * (1.0f / QLORA) + RMS_EPS) * QSCALE;
        u32x2 o; o.x = pk2(a0 * rs, a1 * rs); o.y = pk2(a2 * rs, a3 * rs); *(u32x2*)(C.Q + (size_t)m * 768 + n0) = o;
    });
    naive_gemm(C, C.PS + QLORA, PSW, C.WUKV, KVLORA, M, 1024, KVLORA, [&](int m, int n0, float a0, float a1, float a2, float a3, float ss) {
        const float rs = rsqrtf(ss * (1.0f / KVLORA) + RMS_EPS);
        u32x2 o; o.x = pk2(a0 * rs, a1 * rs); o.y = pk2(a2 * rs, a3 * rs); *(u32x2*)(C.KV + (size_t)m * 1024 + n0) = o;
    });
    for (long idx = gt_id(); idx < (long)M * 16; idx += C.ngt) {
        const int m = (int)(idx >> 4), j = (int)(idx & 15), pos = m % SEQ;
        const float c = C.ROPET[2 * (pos * 16 + j)], s = C.ROPET[2 * (pos * 16 + j) + 1];
        const float t1 = bf2f(C.PS[(size_t)m * PSW + 640 + j]), t2 = bf2f(C.PS[(size_t)m * PSW + 656 + j]);
        C.KR[(size_t)m * 32 + j] = (bf16_t)f2bf(t1 * c - t2 * s); C.KR[(size_t)m * 32 + 16 + j] = (bf16_t)f2bf(t1 * s + t2 * c);
    }
}
__device__ __forceinline__ void p2b_naive_qrope(Ctx& C) {
    for (long idx = gt_id(); idx < (long)M * NH * 16; idx += C.ngt) {
        const int j = (int)(idx & 15), h = (int)((idx >> 4) & 7), m = (int)(idx >> 7), pos = m % SEQ;
        const float c = C.ROPET[2 * (pos * 16 + j)], s = C.ROPET[2 * (pos * 16 + j) + 1];
        bf16_t* p = C.Q + (size_t)m * 768 + h * 96 + 64 + j;
        const float t1 = bf2f(p[0]), t2 = bf2f(p[16]);
        p[0] = (bf16_t)f2bf(t1 * c - t2 * s); p[16] = (bf16_t)f2bf(t1 * s + t2 * c);
    }
}

__device__ __forceinline__ void p3_naive_mla(Ctx& C) {
    for (long idx = gt_id(); idx < (long)BATCH * NH * SEQ; idx += C.ngt) {
        const int q = (int)(idx % SEQ), h = (int)((idx / SEQ) % NH), b = (int)(idx / (SEQ * NH));
        const size_t m = (size_t)b * SEQ + q;
        u32x4 qv[12];
#pragma unroll
        for (int i = 0; i < 12; ++i) qv[i] = *(const u32x4*)(C.Q + m * 768 + h * 96 + i * 8);
        float o[64];
#pragma unroll
        for (int d = 0; d < 64; ++d) o[d] = 0.f;
        float mx = -1e30f, l = 0.f;
        const int kmax = __builtin_amdgcn_readfirstlane(q | 63);
        for (int k = 0; k <= kmax; ++k) {
            const size_t mk = (size_t)b * SEQ + k;
            const bf16_t* kp = C.KV + mk * 1024 + h * 128; const bf16_t* rp = C.KR + mk * 32;
            float s = 0.f;
#pragma unroll
            for (int i = 0; i < 8; ++i) { const u32x4 kv = *(const u32x4*)(kp + i * 8);
#pragma unroll
                for (int e = 0; e < 4; ++e) s += lo16(qv[i][e]) * lo16(kv[e]) + hi16(qv[i][e]) * hi16(kv[e]); }
#pragma unroll
            for (int i = 0; i < 4; ++i) { const u32x4 kv = *(const u32x4*)(rp + i * 8);
#pragma unroll
                for (int e = 0; e < 4; ++e) s += lo16(qv[8 + i][e]) * lo16(kv[e]) + hi16(qv[8 + i][e]) * hi16(kv[e]); }
            if (k <= q) {
                const float mn = fmaxf(mx, s), f = exp2f(mx - mn), p = exp2f(s - mn);
                l = l * f + p; mx = mn;
#pragma unroll
                for (int i = 0; i < 8; ++i) { const u32x4 vv = *(const u32x4*)(kp + 64 + i * 8);
#pragma unroll
                    for (int e = 0; e < 4; ++e) { o[i * 8 + 2 * e] = o[i * 8 + 2 * e] * f + p * lo16(vv[e]); o[i * 8 + 2 * e + 1] = o[i * 8 + 2 * e + 1] * f + p * hi16(vv[e]); } }
            }
        }
        const float il = 1.0f / l;
        bf16_t* op = C.OAB + m * 512 + h * 64;
#pragma unroll
        for (int i = 0; i < 8; ++i) { u32x4 w; w.x = pk2(o[i * 8] * il, o[i * 8 + 1] * il); w.y = pk2(o[i * 8 + 2] * il, o[i * 8 + 3] * il); w.z = pk2(o[i * 8 + 4] * il, o[i * 8 + 5] * il); w.w = pk2(o[i * 8 + 6] * il, o[i * 8 + 7] * il); *(u32x4*)(op + i * 8) = w; }
    }
}
__device__ __forceinline__ void p3_naive_dil(Ctx& C) {
    for (long idx = gt_id(); idx < (long)BATCH * NH * SEQ; idx += C.ngt) {
        const int t = (int)(idx % SEQ), h = (int)((idx / SEQ) % NH), b = (int)(idx / (SEQ * NH));
        const size_t m = (size_t)b * SEQ + t;
        const float slope = exp2f(-(float)(h + 1));
        u32x4 qv[8];
#pragma unroll
        for (int i = 0; i < 8; ++i) qv[i] = *(const u32x4*)(C.QKVD + m * QKVDW + h * 64 + i * 8);
        float num[64];
#pragma unroll
        for (int d = 0; d < 64; ++d) num[d] = 0.f;
        float m_all = -1e30f, tot = 0.f;
        for (int p = 0; p < 3; ++p) {
            const int dil = (p == 0) ? 1 : (p == 1 ? 4 : 16);
            float o[64];
#pragma unroll
            for (int d = 0; d < 64; ++d) o[d] = 0.f;
            float mx = -1e30f, l = 0.f;
            for (int j = 0; j <= 128; ++j) {
                const int tk = t - j * dil; if (tk < 0) break;
                const bf16_t* kp = C.QKVD + ((size_t)b * SEQ + tk) * QKVDW + 512 + h * 64;
                float s = 0.f;
#pragma unroll
                for (int i = 0; i < 8; ++i) { const u32x4 kv = *(const u32x4*)(kp + i * 8);
#pragma unroll
                    for (int e = 0; e < 4; ++e) s += lo16(qv[i][e]) * lo16(kv[e]) + hi16(qv[i][e]) * hi16(kv[e]); }
                s = s * 0.125f - slope * (float)(dil * j);
                const float mn = fmaxf(mx, s), f = __expf(mx - mn), pe = __expf(s - mn);
                l = l * f + pe; mx = mn;
#pragma unroll
                for (int i = 0; i < 8; ++i) { const u32x4 vv = *(const u32x4*)(kp + 512 + i * 8);
#pragma unroll
                    for (int e = 0; e < 4; ++e) { o[i * 8 + 2 * e] = o[i * 8 + 2 * e] * f + pe * lo16(vv[e]); o[i * 8 + 2 * e + 1] = o[i * 8 + 2 * e + 1] * f + pe * hi16(vv[e]); } }
            }
            const float mn = fmaxf(m_all, mx), fa = __expf(m_all - mn), fb = __expf(mx - mn);
            tot = tot * fa + l * fb; m_all = mn;
#pragma unroll
            for (int d = 0; d < 64; ++d) num[d] = num[d] * fa + o[d] * fb;
        }
        const float it = 1.0f / tot;
        bf16_t* op = C.OAB + ((size_t)M + m) * 512 + h * 64;
#pragma unroll
        for (int i = 0; i < 8; ++i) { u32x4 w; w.x = pk2(num[i * 8] * it, num[i * 8 + 1] * it); w.y = pk2(num[i * 8 + 2] * it, num[i * 8 + 3] * it); w.z = pk2(num[i * 8 + 4] * it, num[i * 8 + 5] * it); w.w = pk2(num[i * 8 + 6] * it, num[i * 8 + 7] * it); *(u32x4*)(op + i * 8) = w; }
    }
}
__device__ __forceinline__ void p4_naive(Ctx& C) {
    naive_gemm(C, C.OAB, 512, C.WOAB, 512, M, 1024, 512, [&](int m, int n0, float a0, float a1, float a2, float a3, float) {
        const u32x2 g = *(const u32x2*)(C.GATES + (size_t)m * GATEW + n0);
        u32x2 o; o.x = pk2(a0 * lo16(g.x), a1 * hi16(g.x)); o.y = pk2(a2 * lo16(g.y), a3 * hi16(g.y)); *(u32x2*)(C.T + (size_t)m * 1024 + n0) = o;
    });
}
__device__ __forceinline__ void p4b_naive(Ctx& C) {
    naive_gemm(C, C.OAB + (size_t)M * 512, 512, C.WOAB + (size_t)1024 * 512, 512, M, 1024, 512, [&](int m, int n0, float a0, float a1, float a2, float a3, float) {
        const u32x2 g = *(const u32x2*)(C.GATES + (size_t)m * GATEW + 1024 + n0); const u32x2 t = *(const u32x2*)(C.T + (size_t)m * 1024 + n0);
        u32x2 o; o.x = pk2(lo16(t.x) + a0 * lo16(g.x), hi16(t.x) + a1 * hi16(g.x)); o.y = pk2(lo16(t.y) + a2 * lo16(g.y), hi16(t.y) + a3 * hi16(g.y)); *(u32x2*)(C.MIXIN + (size_t)m * 1024 + n0) = o;
    });
}
__device__ __forceinline__ void p5_naive(Ctx& C) {
    naive_gemm(C, C.MIXIN, 1024, C.WOUT, 1024, M, 1024, 1024, [&](int m, int n0, float a0, float a1, float a2, float a3, float) {
        const f32x4 xv = *(const f32x4*)(C.x + (size_t)m * DM + n0);
        *(f32x4*)(C.out + (size_t)m * DM + n0) = (f32x4){ALPHA * xv.x + a0, ALPHA * xv.y + a1, ALPHA * xv.z + a2, ALPHA * xv.w + a3};
    });
}
__device__ __forceinline__ void ln_rows(Ctx& C, const float* g, const float* bta, bf16_t* hb, float* dst = nullptr) {
    for (int m = C.gw; m < M; m += C.ngw) {
        f32x4* xr = (f32x4*)(C.out + (size_t)m * DM) + lane_id(); f32x4* xw = dst ? (f32x4*)(dst + (size_t)m * DM) + lane_id() : xr;
        f32x4 v[4]; float s = 0.f;
#pragma unroll
        for (int j = 0; j < 4; ++j) { v[j] = xr[64 * j]; s += (v[j].x + v[j].y) + (v[j].z + v[j].w); }
        const float mean = wave_sum(s) * (1.f / DM); float s2 = 0.f;
#pragma unroll
        for (int j = 0; j < 4; ++j) { v[j] = v[j] - mean; s2 += (v[j].x * v[j].x + v[j].y * v[j].y) + (v[j].z * v[j].z + v[j].w * v[j].w); }
        const float rstd = rsqrtf(wave_sum(s2) * (1.f / DM) + LN_EPS);
#pragma unroll
        for (int j = 0; j < 4; ++j) {
            const f32x4 gg = ((const f32x4*)g)[lane_id() + 64 * j], bb = ((const f32x4*)bta)[lane_id() + 64 * j];
            const f32x4 o = v[j] * rstd * gg + bb; xw[64 * j] = o;
            if (hb) { u32x2 w; w.x = pk2(o.x, o.y); w.y = pk2(o.z, o.w); ((u32x2*)(hb + (size_t)m * DM))[lane_id() + 64 * j] = w; }
        }
    }
}
__device__ __forceinline__ void p7_naive(Ctx& C) {
    naive_gemm(C, C.HB, DM, C.WFF1, DM, M, DFF, DM, [&](int m, int n0, float a0, float a1, float a2, float a3, float) {
        a0 = fmaxf(a0, 0.f); a1 = fmaxf(a1, 0.f); a2 = fmaxf(a2, 0.f); a3 = fmaxf(a3, 0.f);
        u32x2 o; o.x = pk2(a0 * a0, a1 * a1); o.y = pk2(a2 * a2, a3 * a3); *(u32x2*)(C.HID + (size_t)m * DFF + n0) = o;
    });
}
__device__ __forceinline__ void p8_naive(Ctx& C) {
    naive_gemm(C, C.HID, DFF, C.WFF2, DFF, M, DM, DFF, [&](int m, int n0, float a0, float a1, float a2, float a3, float) {
        f32x4* p = (f32x4*)(C.out + (size_t)m * DM + n0); const f32x4 hv = *p;
        *p = (f32x4){ALPHA * hv.x + a0, ALPHA * hv.y + a1, ALPHA * hv.z + a2, ALPHA * hv.w + a3};
    });
}

namespace pg8 {
typedef short bf16x8 __attribute__((ext_vector_type(8)));
constexpr int BM = 256, BK = 64, HALF = 128, HTB = HALF * BK * 2, STAGE_BYTES = 8 * HTB, NXCD = 8, WGM = 8;
__host__ __device__ __forceinline__ int lds_byte(int r, int c) { const int st = (r >> 4) * 2 + (c >> 5), rr = r & 15, cc = c & 31, ob = rr * 64 + cc * 2; return st * 1024 + (ob ^ (((ob >> 9) & 1) << 5)); }
__host__ __device__ __forceinline__ void stage_rc(int b, int& R, int& C) { const int st = b / 1024, sb = b % 1024, swz = sb ^ (((sb >> 9) & 1) << 5); R = (st >> 1) * 16 + swz / 64; C = (st & 1) * 32 + (swz % 64) / 2; }
__host__ __device__ __forceinline__ int perm32(int rho) { const int n = rho >> 4, i = rho & 15; return 8 * (i >> 2) + 4 * n + (i & 3); }
struct Unit { int pm, pn; };
struct Gemm { const bf16_t* A; const bf16_t* Bt; int K, lda, ldb; };
__device__ __forceinline__ void swz_tile(int L, int nM, int nN, Unit& u) {
    const int nwg = nM * nN; int wgid = L;
    { const int q = nwg / NXCD, r = nwg % NXCD, xcd = wgid % NXCD, off = wgid / NXCD; wgid = (xcd < r ? xcd * (q + 1) : r * (q + 1) + (xcd - r) * q) + off; }
    const int nig = WGM * nN, gid = wgid / nig, fm = gid * WGM, gsz = (nM - fm) < WGM ? (nM - fm) : WGM;
    u.pm = fm + ((wgid % nig) % gsz); u.pn = (wgid % nig) / gsz;
}
struct StaticOrder {
    int nM, nN, nwg, G, c;
    __device__ void init(int Mr, int N, int G_, int c_) { nM = Mr / BM; nN = N / BM; nwg = nM * nN; G = G_; c = c_; }
    __device__ bool next(int i, Unit& u) const { const long L = (long)i * G + c; if (L >= nwg) return false; swz_tile((int)L, nM, nN, u); return true; }
};
struct PairOrder {
    int nM, nN, nwg, G, c;
    __device__ void init(int Mr, int N, int G_, int c_) { nM = Mr / BM; nN = N / BM; nwg = nM * nN; G = G_; c = c_; }
    __device__ bool next(int i, Unit& u) const { const long L = (long)(i >> 1) * G + c; if (L >= nwg) return false; swz_tile((int)L, nM, nN, u); if (i & 1) { u.pm += nM; u.pn += nN; } return true; }
};
__device__ __forceinline__ unsigned cvt_pk_bf16(float lo, float hi) { unsigned r; asm volatile("v_cvt_pk_bf16_f32 %0, %1, %2" : "=v"(r) : "v"(lo), "v"(hi)); return r; }

template <class Epi, class Sched, bool ALIGN_EPI>
__device__ __forceinline__ void gemm_phase(LAS unsigned char* lds, const Gemm g, const Sched& S, const Epi& E) {
    int tid = threadIdx.x; asm volatile("" : "+v"(tid));
    const int wid = __builtin_amdgcn_readfirstlane(tid >> 6), lane = tid & 63, wr = wid >> 2, wc = wid & 3, fr = lane & 15, fq = lane >> 4;
    const int K = g.K, nt = K / BK;
    unsigned voffA[2], voffB[2];
#pragma unroll
    for (int i = 0; i < 2; ++i) { int R, C; stage_rc(tid * 16 + i * 8192, R, C); const int Rb = Epi::PERM ? ((R & ~31) + perm32(R & 31)) : R;
        voffA[i] = (unsigned)(R * g.lda + C) * 2u; voffB[i] = (unsigned)(Rb * g.ldb + C) * 2u; }
    const size_t kstep = (size_t)(BK * 2);
    const size_t hstepA = (size_t)HALF * g.lda * 2, hstepB = (size_t)HALF * g.ldb * 2;
    const size_t tstepA = 2 * hstepA, tstepB = 2 * hstepB;
    const unsigned ldsw = (unsigned)wid * 1024u;
    const int aoff = lds_byte(wr * 64 + fr, fq * 8), boff = lds_byte(wc * 32 + fr, fq * 8);
#define PG8_SA(b, h) (((b) * 2 + (h)) * HTB)
#define PG8_SB(b, h) ((4 + (b) * 2 + (h)) * HTB)
#define PG8_STAGE(bufoff, gbase, voff) do { _Pragma("unroll") for (int _i = 0; _i < 2; ++_i) \
        __builtin_amdgcn_global_load_lds((const unsigned*)((const char*)(gbase) + (voff)[_i]), (LAS unsigned*)(lds + (bufoff) + ldsw + _i * 8192), 16, 0, 0); } while (0)
#define PG8_LDA(dst, b, h) do { _Pragma("unroll") for (int m = 0; m < 4; ++m) _Pragma("unroll") for (int k = 0; k < 2; ++k) dst[m][k] = *(const LAS bf16x8*)(lds + PG8_SA(b, h) + aoff + m * 2048 + k * 1024); } while (0)
#define PG8_LDB(dst, b, h) do { _Pragma("unroll") for (int n = 0; n < 2; ++n) _Pragma("unroll") for (int k = 0; k < 2; ++k) dst[n][k] = *(const LAS bf16x8*)(lds + PG8_SB(b, h) + boff + n * 2048 + k * 1024); } while (0)
#define PG8_MMA(ai, bj, At, Bt) do { __builtin_amdgcn_s_setprio(1); _Pragma("unroll") for (int m = 0; m < 4; ++m) _Pragma("unroll") for (int n = 0; n < 2; ++n) _Pragma("unroll") for (int k = 0; k < 2; ++k) \
        acc[ai][bj][m][n] = __builtin_amdgcn_mfma_f32_16x16x32_bf16(Bt[n][k], At[m][k], acc[ai][bj][m][n], 0, 0, 0); __builtin_amdgcn_s_setprio(0); } while (0)
#define PG8_WAIT_V(n) asm volatile("s_waitcnt vmcnt(" #n ")" ::: "memory")
#define PG8_WAIT_L(n) asm volatile("s_waitcnt lgkmcnt(" #n ")" ::: "memory")
#define PG8_BAR __builtin_amdgcn_s_barrier()
#define PG8_SCHED __builtin_amdgcn_sched_barrier(0)
    Unit cur, nxt; int ui = 0;
    if (!S.next(0, cur)) return;
    f32x4 acc[2][2][4][2];
#pragma unroll
    for (int a = 0; a < 2; ++a)
#pragma unroll
        for (int b = 0; b < 2; ++b)
#pragma unroll
            for (int m = 0; m < 4; ++m)
#pragma unroll
                for (int n = 0; n < 2; ++n) acc[a][b][m][n] = (f32x4){0.f, 0.f, 0.f, 0.f};
    bf16x8 At[4][2], B0[2][2], B1[2][2];
    const char* cA = (const char*)g.A + (size_t)cur.pm * tstepA; const char* cB = (const char*)g.Bt + (size_t)cur.pn * tstepB;
    PG8_STAGE(PG8_SB(0, 0), cB, voffB); PG8_STAGE(PG8_SB(0, 1), cB + hstepB, voffB); PG8_STAGE(PG8_SA(0, 0), cA, voffA); PG8_STAGE(PG8_SA(0, 1), cA + hstepA, voffA);
    if (wr == 1) PG8_BAR;
    PG8_WAIT_V(2); PG8_BAR;
    PG8_STAGE(PG8_SB(1, 0), cB + kstep, voffB); PG8_STAGE(PG8_SA(1, 0), cA + kstep, voffA); PG8_STAGE(PG8_SB(1, 1), cB + hstepB + kstep, voffB);
    PG8_WAIT_V(6); PG8_BAR;
    for (;;) {
        const bool has_next = S.next(ui + 1, nxt);
        const char* nA = has_next ? (const char*)g.A + (size_t)nxt.pm * tstepA : cA; const char* nB = has_next ? (const char*)g.Bt + (size_t)nxt.pn * tstepB : cB;
#pragma nounroll
        for (int t = 0; t < nt; t += 2) {
            const bool last = (t == nt - 2);
            const char* a1 = cA + (size_t)(t + 1) * kstep;
            const char* a2 = last ? nA : cA + (size_t)(t + 2) * kstep; const char* b2 = last ? nB : cB + (size_t)(t + 2) * kstep;
            const char* a3 = a2 + kstep; const char* b3 = b2 + kstep;
            PG8_LDB(B0, 0, 0); PG8_LDB(B1, 0, 1); PG8_SCHED; PG8_LDA(At, 0, 0); PG8_STAGE(PG8_SA(1, 1), a1 + hstepA, voffA);
            PG8_WAIT_V(8); PG8_WAIT_L(0); PG8_BAR; PG8_MMA(0, 0, At, B0); PG8_MMA(0, 1, At, B1); PG8_BAR; PG8_SCHED;
            PG8_LDA(At, 0, 1); PG8_STAGE(PG8_SB(0, 0), b2, voffB); PG8_STAGE(PG8_SB(0, 1), b2 + hstepB, voffB); PG8_STAGE(PG8_SA(0, 0), a2, voffA);
            PG8_WAIT_V(8); PG8_WAIT_L(0); PG8_BAR; PG8_MMA(1, 0, At, B0); PG8_MMA(1, 1, At, B1); PG8_BAR; PG8_SCHED;
            PG8_LDB(B0, 1, 0); PG8_LDB(B1, 1, 1); PG8_SCHED; PG8_LDA(At, 1, 0); PG8_STAGE(PG8_SA(0, 1), a2 + hstepA, voffA);
            PG8_WAIT_V(8); PG8_WAIT_L(0); PG8_BAR; PG8_MMA(0, 0, At, B0); PG8_MMA(0, 1, At, B1); PG8_BAR; PG8_SCHED;
            PG8_LDA(At, 1, 1); PG8_STAGE(PG8_SB(1, 0), b3, voffB); PG8_STAGE(PG8_SB(1, 1), b3 + hstepB, voffB); PG8_STAGE(PG8_SA(1, 0), a3, voffA);
            PG8_WAIT_V(8); PG8_WAIT_L(0); PG8_BAR; PG8_MMA(1, 0, At, B0); PG8_MMA(1, 1, At, B1); PG8_BAR; PG8_SCHED;
        }
        if constexpr (ALIGN_EPI) { if (wr == 0) PG8_BAR; }
        E(acc, cur, wr, wc, fr, fq);
        if (!has_next) break;
#pragma unroll
        for (int a = 0; a < 2; ++a)
#pragma unroll
            for (int b = 0; b < 2; ++b)
#pragma unroll
                for (int m = 0; m < 4; ++m)
#pragma unroll
                    for (int n = 0; n < 2; ++n) acc[a][b][m][n] = (f32x4){0.f, 0.f, 0.f, 0.f};
        cur = nxt; cA = nA; cB = nB; ++ui;
        if constexpr (ALIGN_EPI) { if (wr == 1) PG8_BAR; }
    }
    PG8_WAIT_V(0);
    if constexpr (!ALIGN_EPI) { if (wr == 0) PG8_BAR; }
    PG8_BAR;
#undef PG8_SA
#undef PG8_SB
#undef PG8_STAGE
#undef PG8_LDA
#undef PG8_LDB
#undef PG8_MMA
#undef PG8_WAIT_V
#undef PG8_WAIT_L
#undef PG8_BAR
#undef PG8_SCHED
}

typedef f32x4 AccT[2][2][4][2];
__device__ __forceinline__ float sigm(float v) { return __builtin_amdgcn_rcpf(1.0f + __builtin_amdgcn_exp2f(-LOG2E * v)); }
__device__ __forceinline__ u32x4 pack8(const f32x4 v0, const f32x4 v1) { u32x4 w; w.x = cvt_pk_bf16(v0[0], v0[1]); w.y = cvt_pk_bf16(v0[2], v0[3]); w.z = cvt_pk_bf16(v1[0], v1[1]); w.w = cvt_pk_bf16(v1[2], v1[3]); return w; }

struct EpiIn {
    static constexpr bool PERM = true;
    bf16_t *PS, *QKVD, *GATES; const float* b_gate; float* SUMSQ; bool do_ss;
    __device__ __forceinline__ void operator()(const AccT& acc, const Unit& u, int wr, int wc, int fr, int fq) const {
        const int row0 = u.pm * BM + wr * 64 + fr;
        int kind, ldc, colt; bf16_t* base;
        if (u.pn < 3) { kind = 0; base = PS; ldc = PSW; colt = u.pn * BM; } else if (u.pn < 9) { kind = 1; base = QKVD; ldc = QKVDW; colt = (u.pn - 3) * BM; } else { kind = 2; base = GATES; ldc = GATEW; colt = (u.pn - 9) * BM; }
        const int col0 = colt + wc * 32 + 8 * fq;
        f32x4 bv[2][2];
#pragma unroll
        for (int bj = 0; bj < 2; ++bj)
#pragma unroll
            for (int n = 0; n < 2; ++n) bv[bj][n] = (kind == 2) ? *(const f32x4*)(b_gate + col0 + bj * HALF + 4 * n) : (f32x4){0.f, 0.f, 0.f, 0.f};
#pragma unroll
        for (int ai = 0; ai < 2; ++ai)
#pragma unroll
            for (int m = 0; m < 4; ++m) { const int row = row0 + ai * HALF + m * 16; bf16_t* rowp = base + (size_t)row * ldc + col0;
#pragma unroll
                for (int bj = 0; bj < 2; ++bj) { f32x4 v0 = acc[ai][bj][m][0], v1 = acc[ai][bj][m][1];
                    if (kind == 2) { v0 += bv[bj][0]; v1 += bv[bj][1];
#pragma unroll
                        for (int e = 0; e < 4; ++e) { v0[e] = sigm(v0[e]); v1[e] = sigm(v1[e]); } }
                    *(u32x4*)(rowp + bj * HALF) = pack8(v0, v1);
                    if (kind == 0) {
                        float ss = (v0[0] * v0[0] + v0[1] * v0[1]) + (v0[2] * v0[2] + v0[3] * v0[3]) + (v1[0] * v1[0] + v1[1] * v1[1]) + (v1[2] * v1[2] + v1[3] * v1[3]);
                        ss += __shfl_xor(ss, 16); ss += __shfl_xor(ss, 32);
                        const int t = (u.pn == 0) ? 0 : (u.pn == 1 ? bj : (bj == 0 ? 1 : -1));
                        if (fq == 0 && t >= 0 && do_ss) atomicAdd(SUMSQ + (size_t)row * 2 + t, ss);
                    } } }
    }
};
struct EpiQ {
    static constexpr bool PERM = false;
    bf16_t* __restrict__ Q; const float* __restrict__ SUMSQ; const float* __restrict__ ROPET;
    __device__ __forceinline__ void operator()(const AccT& acc, const Unit& u, int wr, int wc, int fr, int fq) const {
        const int row0 = u.pm * BM + wr * 64 + fr;
        const bool rope0 = ((u.pn * 8 + wc) % 3) == 2, rope1 = ((u.pn * 8 + 4 + wc) % 3) == 2;
#pragma unroll
        for (int ai = 0; ai < 2; ++ai) {
            float rs[4]; f32x4 c0[4], c1[4];
#pragma unroll
            for (int m = 0; m < 4; ++m) { const int row = row0 + ai * HALF + m * 16; const int pos = row & (SEQ - 1);
                rs[m] = SUMSQ[(size_t)row * 2];
                c0[m] = *(const f32x4*)(ROPET + (size_t)(pos * 16 + 4 * fq) * 2); c1[m] = *(const f32x4*)(ROPET + (size_t)(pos * 16 + 4 * fq) * 2 + 4); }
#pragma unroll
            for (int m = 0; m < 4; ++m) { const int row = row0 + ai * HALF + m * 16;
                const float r = rsqrtf(rs[m] * (1.0f / QLORA) + RMS_EPS) * QSCALE;
                const float cs[4] = {c0[m][0], c0[m][2], c1[m][0], c1[m][2]}, sn[4] = {c0[m][1], c0[m][3], c1[m][1], c1[m][3]};
#pragma unroll
                for (int bj = 0; bj < 2; ++bj) { const bool rope = bj ? rope1 : rope0;
                    f32x4 v0 = acc[ai][bj][m][0] * r, v1 = acc[ai][bj][m][1] * r;
                    if (rope) { f32x4 o0, o1;
#pragma unroll
                        for (int e = 0; e < 4; ++e) { o0[e] = v0[e] * cs[e] - v1[e] * sn[e]; o1[e] = v0[e] * sn[e] + v1[e] * cs[e]; }
                        v0 = o0; v1 = o1; }
                    bf16_t* p = Q + (size_t)row * 768 + u.pn * BM + bj * HALF + wc * 32 + 4 * fq;
                    u32x2 w0, w1; w0.x = cvt_pk_bf16(v0[0], v0[1]); w0.y = cvt_pk_bf16(v0[2], v0[3]); w1.x = cvt_pk_bf16(v1[0], v1[1]); w1.y = cvt_pk_bf16(v1[2], v1[3]);
                    *(u32x2*)p = w0; *(u32x2*)(p + 16) = w1; } }
        }
    }
};
struct EpiKV {
    static constexpr bool PERM = true;
    bf16_t* __restrict__ KV; const float* __restrict__ SUMSQ;
    __device__ __forceinline__ void operator()(const AccT& acc, const Unit& u, int wr, int wc, int fr, int fq) const {
        const int row0 = u.pm * BM + wr * 64 + fr, col0 = u.pn * BM + wc * 32 + 8 * fq;
        float rs[2][4];
#pragma unroll
        for (int ai = 0; ai < 2; ++ai)
#pragma unroll
            for (int m = 0; m < 4; ++m) rs[ai][m] = SUMSQ[(size_t)(row0 + ai * HALF + m * 16) * 2 + 1];
#pragma unroll
        for (int ai = 0; ai < 2; ++ai)
#pragma unroll
            for (int m = 0; m < 4; ++m) { const int row = row0 + ai * HALF + m * 16;
                const float r = rsqrtf(rs[ai][m] * (1.0f / KVLORA) + RMS_EPS);
#pragma unroll
                for (int bj = 0; bj < 2; ++bj) *(u32x4*)(KV + (size_t)row * 1024 + col0 + bj * HALF) = pack8(acc[ai][bj][m][0] * r, acc[ai][bj][m][1] * r); }
    }
};
struct EpiMix {
    static constexpr bool PERM = true;
    const bf16_t* GATES; bf16_t* T; bf16_t* MIXIN;
    __device__ __forceinline__ void operator()(const AccT& acc, const Unit& u, int wr, int wc, int fr, int fq) const {
        const bool second = u.pm >= 128; const int pm = second ? u.pm - 128 : u.pm, pn = second ? u.pn - 4 : u.pn;
        const int row0 = pm * BM + wr * 64 + fr, col0 = pn * BM + wc * 32 + 8 * fq;
#pragma unroll
        for (int ai = 0; ai < 2; ++ai)
#pragma unroll
          for (int mh = 0; mh < 2; ++mh) {
            u32x4 g[2][2], t[2][2];
#pragma unroll
            for (int mm = 0; mm < 2; ++mm)
#pragma unroll
                for (int bj = 0; bj < 2; ++bj) { const int row = row0 + ai * HALF + (mh * 2 + mm) * 16, col = col0 + bj * HALF;
                    g[mm][bj] = *(const u32x4*)(GATES + (size_t)row * GATEW + (second ? 1024 : 0) + col);
                    t[mm][bj] = second ? *(const u32x4*)(T + (size_t)row * 1024 + col) : (u32x4){0u, 0u, 0u, 0u}; }
            asm volatile("" ::: "memory");
#pragma unroll
            for (int mm = 0; mm < 2; ++mm)
#pragma unroll
                for (int bj = 0; bj < 2; ++bj) { const int m = mh * 2 + mm; const int row = row0 + ai * HALF + m * 16, col = col0 + bj * HALF;
                    const u32x4 gg = g[mm][bj], tt = t[mm][bj];
                    f32x4 v0 = acc[ai][bj][m][0], v1 = acc[ai][bj][m][1];
                    v0[0] = v0[0] * lo16(gg.x) + lo16(tt.x); v0[1] = v0[1] * hi16(gg.x) + hi16(tt.x); v0[2] = v0[2] * lo16(gg.y) + lo16(tt.y); v0[3] = v0[3] * hi16(gg.y) + hi16(tt.y);
                    v1[0] = v1[0] * lo16(gg.z) + lo16(tt.z); v1[1] = v1[1] * hi16(gg.z) + hi16(tt.z); v1[2] = v1[2] * lo16(gg.w) + lo16(tt.w); v1[3] = v1[3] * hi16(gg.w) + hi16(tt.w);
                    *(u32x4*)((second ? MIXIN : T) + (size_t)row * 1024 + col) = pack8(v0, v1); }
            asm volatile("" ::: "memory");
          }
    }
};
struct EpiRes {
    static constexpr bool PERM = false;
    const float* base; float* out;
    __device__ __forceinline__ void operator()(const AccT& acc, const Unit& u, int wr, int wc, int fr, int fq) const {
        const int row0 = u.pm * BM + wr * 64 + fr, col0 = u.pn * BM + wc * 32 + 4 * fq;
#pragma unroll
        for (int ai = 0; ai < 2; ++ai)
#pragma unroll
          for (int mh = 0; mh < 2; ++mh) {
            f32x4 bs[2][2][2];
#pragma unroll
            for (int mm = 0; mm < 2; ++mm) { const size_t off = (size_t)(row0 + ai * HALF + (mh * 2 + mm) * 16) * DM + col0;
#pragma unroll
                for (int bj = 0; bj < 2; ++bj)
#pragma unroll
                    for (int n = 0; n < 2; ++n) bs[mm][bj][n] = *(const f32x4*)(base + off + bj * HALF + n * 16); }
            asm volatile("" ::: "memory");
#pragma unroll
            for (int mm = 0; mm < 2; ++mm) { const int m = mh * 2 + mm; const size_t off = (size_t)(row0 + ai * HALF + m * 16) * DM + col0;
#pragma unroll
                for (int bj = 0; bj < 2; ++bj)
#pragma unroll
                    for (int n = 0; n < 2; ++n) *(f32x4*)(out + off + bj * HALF + n * 16) = bs[mm][bj][n] * ALPHA + acc[ai][bj][m][n]; }
            asm volatile("" ::: "memory");
          }
    }
};
struct EpiSqRelu {
    static constexpr bool PERM = true;
    bf16_t* H;
    __device__ __forceinline__ void operator()(const AccT& acc, const Unit& u, int wr, int wc, int fr, int fq) const {
        const int row0 = u.pm * BM + wr * 64 + fr, col0 = u.pn * BM + wc * 32 + 8 * fq;
#pragma unroll
        for (int ai = 0; ai < 2; ++ai)
#pragma unroll
            for (int m = 0; m < 4; ++m) { bf16_t* rowp = H + (size_t)(row0 + ai * HALF + m * 16) * DFF + col0;
#pragma unroll
                for (int bj = 0; bj < 2; ++bj) { f32x4 v0 = acc[ai][bj][m][0], v1 = acc[ai][bj][m][1];
#pragma unroll
                    for (int e = 0; e < 4; ++e) { const float a = fmaxf(v0[e], 0.f), b = fmaxf(v1[e], 0.f); v0[e] = a * a; v1[e] = b * b; }
                    *(u32x4*)(rowp + bj * HALF) = pack8(v0, v1); } }
    }
};
}

namespace fa {
typedef short bf16x8 __attribute__((ext_vector_type(8)));
typedef short s16x4 __attribute__((ext_vector_type(4)));
typedef short v4i16_t __attribute__((ext_vector_type(4)));
typedef float f32x16 __attribute__((ext_vector_type(16)));
constexpr int VBUF = 4096;
__device__ __forceinline__ s16x4 vtr(LAS const unsigned char* p) { return __builtin_bit_cast(s16x4, __builtin_amdgcn_ds_read_tr16_b64_v4i16((LAS v4i16_t*)p)); }
__device__ __forceinline__ unsigned cvtpk(float lo, float hi) { unsigned r; asm volatile("v_cvt_pk_bf16_f32 %0, %1, %2" : "=v"(r) : "v"(lo), "v"(hi)); return r; }
struct State { f32x16 o0, o1; float m, l; };
__device__ __forceinline__ void st_init(State& st) { st.o0 = f32x16{}; st.o1 = f32x16{}; st.m = -1e30f; st.l = 0.f; }
__device__ __forceinline__ void v_store(LAS unsigned char* vb, const u32x4 (&vr)[4], int lane) {
#pragma unroll
    for (int i = 0; i < 4; ++i) { const int key = (i * 64 + lane) >> 3, c = lane & 7; *(LAS u32x4*)(vb + (c >> 2) * 2048 + key * 64 + (c & 3) * 16) = vr[i]; }
}
__device__ __forceinline__ void softmax_pv(State& st, f32x16& t, LAS const unsigned char* vb, int lane) {
    float mx = fmaxf(fmaxf(t[0], t[1]), fmaxf(t[2], t[3]));
#pragma unroll
    for (int r = 4; r < 16; r += 4) mx = fmaxf(mx, fmaxf(fmaxf(t[r], t[r + 1]), fmaxf(t[r + 2], t[r + 3])));
    mx = fmaxf(mx, __shfl_xor(mx, 32));
    const float mn = fmaxf(st.m, mx);
    if (__any(mn > st.m)) { const float sc = __builtin_amdgcn_exp2f(st.m - mn); st.l *= sc; st.o0 *= sc; st.o1 *= sc; st.m = mn; }
    float sum = 0.f;
#pragma unroll
    for (int r = 0; r < 16; ++r) { t[r] = __builtin_amdgcn_exp2f(t[r] - mn); sum += t[r]; }
    st.l += sum;
    u32x4 w0, w1;
    w0.x = cvtpk(t[0], t[1]); w0.y = cvtpk(t[2], t[3]); w0.z = cvtpk(t[4], t[5]); w0.w = cvtpk(t[6], t[7]);
    w1.x = cvtpk(t[8], t[9]); w1.y = cvtpk(t[10], t[11]); w1.z = cvtpk(t[12], t[13]); w1.w = cvtpk(t[14], t[15]);
    const bf16x8 pf0 = __builtin_bit_cast(bf16x8, w0), pf1 = __builtin_bit_cast(bf16x8, w1);
    LAS const unsigned char* vp = vb + (4 * (lane >> 5) + ((lane & 15) >> 2)) * 64 + (16 * ((lane >> 4) & 1) + 4 * (lane & 3)) * 2;
#define FA_VF(d0, s) ([&]() { const s16x4 a = vtr(vp + (d0) * 2048 + (s) * 1024), b = vtr(vp + (d0) * 2048 + (s) * 1024 + 512); return (bf16x8){a[0], a[1], a[2], a[3], b[0], b[1], b[2], b[3]}; }())
    const bf16x8 v00 = FA_VF(0, 0), v01 = FA_VF(0, 1), v10 = FA_VF(1, 0), v11 = FA_VF(1, 1);
#undef FA_VF
    st.o0 = __builtin_amdgcn_mfma_f32_32x32x16_bf16(v00, pf0, st.o0, 0, 0, 0);
    st.o1 = __builtin_amdgcn_mfma_f32_32x32x16_bf16(v10, pf0, st.o1, 0, 0, 0);
    st.o0 = __builtin_amdgcn_mfma_f32_32x32x16_bf16(v01, pf1, st.o0, 0, 0, 0);
    st.o1 = __builtin_amdgcn_mfma_f32_32x32x16_bf16(v11, pf1, st.o1, 0, 0, 0);
}
__device__ __forceinline__ void o_store(State& st, bf16_t* orow, int lane) {
    const float lt = st.l + __shfl_xor(st.l, 32); const float il = 1.0f / lt; const int hi = lane >> 5;
#pragma unroll
    for (int rr = 0; rr < 4; ++rr) {
        u32x2 a, b; a.x = cvtpk(st.o0[4 * rr] * il, st.o0[4 * rr + 1] * il); a.y = cvtpk(st.o0[4 * rr + 2] * il, st.o0[4 * rr + 3] * il);
        b.x = cvtpk(st.o1[4 * rr] * il, st.o1[4 * rr + 1] * il); b.y = cvtpk(st.o1[4 * rr + 2] * il, st.o1[4 * rr + 3] * il);
        *(u32x2*)(orow + 8 * rr + 4 * hi) = a; *(u32x2*)(orow + 32 + 8 * rr + 4 * hi) = b;
    }
}
__device__ __forceinline__ void mla_item(const bf16_t* Q, const bf16_t* KV, const bf16_t* KR, bf16_t* O, int b, int h, int qt, LAS unsigned char* vl, int lane) {
    const int r32 = lane & 31, hi = lane >> 5;
    const size_t mq = (size_t)b * SEQ + 32 * qt + r32;
    bf16x8 qf[6];
#pragma unroll
    for (int ds = 0; ds < 6; ++ds) qf[ds] = *(const bf16x8*)(Q + mq * 768 + h * 96 + 16 * ds + 8 * hi);
    State st; st_init(st);
    bf16x8 kn[6]; u32x4 vr[4];
#define MLA_LOAD(kt) do { const size_t mk_ = (size_t)b * SEQ + 32 * (kt) + r32; \
        _Pragma("unroll") for (int ds = 0; ds < 4; ++ds) kn[ds] = *(const bf16x8*)(KV + mk_ * 1024 + h * 128 + 16 * ds + 8 * hi); \
        _Pragma("unroll") for (int e = 0; e < 2; ++e) kn[4 + e] = *(const bf16x8*)(KR + mk_ * 32 + 16 * e + 8 * hi); \
        _Pragma("unroll") for (int i = 0; i < 4; ++i) vr[i] = *(const u32x4*)(KV + ((size_t)b * SEQ + 32 * (kt) + ((i * 64 + lane) >> 3)) * 1024 + h * 128 + 64 + (lane & 7) * 8); } while (0)
    MLA_LOAD(0);
    v_store(vl, vr, lane);
    for (int kt = 0; kt <= qt; ++kt) {
        bf16x8 kf[6];
#pragma unroll
        for (int ds = 0; ds < 6; ++ds) kf[ds] = kn[ds];
        if (kt < qt) MLA_LOAD(kt + 1);
        f32x16 s = f32x16{};
#pragma unroll
        for (int ds = 0; ds < 6; ++ds) s = __builtin_amdgcn_mfma_f32_32x32x16_bf16(kf[ds], qf[ds], s, 0, 0, 0);
        if (kt == qt) {
#pragma unroll
            for (int r = 0; r < 16; ++r) { const int key = (r & 3) + 8 * (r >> 2) + 4 * hi; if (key > r32) s[r] = -INFINITY; }
        }
        asm volatile("" ::: "memory");
        softmax_pv(st, s, vl + (kt & 1) * VBUF, lane);
        asm volatile("" ::: "memory");
        if (kt < qt) v_store(vl + ((kt + 1) & 1) * VBUF, vr, lane);
    }
#undef MLA_LOAD
    o_store(st, O + mq * 512 + h * 64, lane);
}
__device__ __forceinline__ void dil_item(const bf16_t* QKVD, bf16_t* O, int b, int h, int r, int pb, LAS unsigned char* vl, int lane) {
    const int r32 = lane & 31, hi = lane >> 5;
    const size_t mq = (size_t)b * SEQ + 4 * (32 * pb + r32) + r;
    bf16x8 qf[4];
#pragma unroll
    for (int ds = 0; ds < 4; ++ds) qf[ds] = *(const bf16x8*)(QKVD + mq * QKVDW + h * 64 + 16 * ds + 8 * hi);
    const float slope2 = __builtin_amdgcn_exp2f(-(float)(h + 1)) * LOG2E;
    constexpr float C1 = 0.125f * LOG2E;
    State st; st_init(st);
    const int nt = (pb + 1) + (pb >= 1 ? 6 : 3);
    bf16x8 kn[4]; u32x4 vr[4];
#define DIL_TILE(t, rho, kb) do { if ((t) <= pb) { rho = r; kb = (t); } else { const int u_ = (t) - (pb + 1); if (pb >= 1) { rho = (r + 1 + (u_ >> 1)) & 3; kb = pb - 1 + (u_ & 1); } else { rho = (r + 1 + u_) & 3; kb = 0; } } } while (0)
#define DIL_LOAD(rho, kb) do { const size_t mk_ = (size_t)b * SEQ + 4 * (32 * (kb) + r32) + (rho); \
        _Pragma("unroll") for (int ds = 0; ds < 4; ++ds) kn[ds] = *(const bf16x8*)(QKVD + mk_ * QKVDW + 512 + h * 64 + 16 * ds + 8 * hi); \
        _Pragma("unroll") for (int i = 0; i < 4; ++i) vr[i] = *(const u32x4*)(QKVD + ((size_t)b * SEQ + 4 * (32 * (kb) + ((i * 64 + lane) >> 3)) + (rho)) * QKVDW + 1024 + h * 64 + (lane & 7) * 8); } while (0)
    int rho, kb; DIL_TILE(0, rho, kb);
    DIL_LOAD(rho, kb);
    v_store(vl, vr, lane);
    for (int t = 0; t < nt; ++t) {
        bf16x8 kf[4];
#pragma unroll
        for (int ds = 0; ds < 4; ++ds) kf[ds] = kn[ds];
        const int dbase = 128 * (pb - kb) + (r - rho);
        int rho2 = 0, kb2 = 0;
        if (t + 1 < nt) { DIL_TILE(t + 1, rho2, kb2); DIL_LOAD(rho2, kb2); }
        f32x16 s = f32x16{};
#pragma unroll
        for (int ds = 0; ds < 4; ++ds) s = __builtin_amdgcn_mfma_f32_32x32x16_bf16(kf[ds], qf[ds], s, 0, 0, 0);
        const int dl = dbase + 4 * r32 - 16 * hi;
#pragma unroll
        for (int rg = 0; rg < 16; ++rg) {
            const int d = dl - 4 * ((rg & 3) + 8 * (rg >> 2));
            const int w = (d <= 128 ? 1 : 0) + (((d & 3) == 0 && d <= 512) ? 1 : 0) + ((d & 15) == 0 ? 1 : 0);
            const float lw = (d < 0 || w == 0) ? -INFINITY : (w == 1 ? 0.f : (w == 2 ? 1.f : 1.5849625007f));
            s[rg] = s[rg] * C1 - slope2 * (float)d + lw;
        }
        asm volatile("" ::: "memory");
        softmax_pv(st, s, vl + (t & 1) * VBUF, lane);
        asm volatile("" ::: "memory");
        if (t + 1 < nt) v_store(vl + ((t + 1) & 1) * VBUF, vr, lane);
        rho = rho2; kb = kb2;
    }
#undef DIL_TILE
#undef DIL_LOAD
    o_store(st, O + ((size_t)M + mq) * 512 + h * 64, lane);
}
}
__device__ __forceinline__ void p3_fast_mla_only(Ctx& C, LAS unsigned char* lds) {
    LAS unsigned char* vl = lds + C.wave * (2 * fa::VBUF);
    for (int pid = C.gw; pid < BATCH * NH * 32; pid += C.ngw) {
        const int bh = pid >> 5, sidx = pid & 31;
        fa::mla_item(C.Q, C.KV, C.KR, C.OAB, bh >> 3, bh & 7, 63 - sidx, vl, lane_id());
        fa::mla_item(C.Q, C.KV, C.KR, C.OAB, bh >> 3, bh & 7, sidx, vl, lane_id());
    }
}
__device__ __forceinline__ void p3_fast_dil_only(Ctx& C, LAS unsigned char* lds) {
    LAS unsigned char* vl = lds + C.wave * (2 * fa::VBUF);
    for (int pid = C.gw; pid < BATCH * NH * 32; pid += C.ngw) {
        const int bh = pid >> 5, r = (pid >> 3) & 3, sidx = pid & 7;
        fa::dil_item(C.QKVD, C.OAB, bh >> 3, bh & 7, r, 15 - sidx, vl, lane_id());
        fa::dil_item(C.QKVD, C.OAB, bh >> 3, bh & 7, r, sidx, vl, lane_id());
    }
}
__device__ __forceinline__ void p3_fast(Ctx& C, LAS unsigned char* lds) {
    LAS unsigned char* vl = lds + C.wave * (2 * fa::VBUF);
    for (int pid = C.gw; pid < BATCH * NH * 32; pid += C.ngw) {
        const int bh = pid >> 5, sidx = pid & 31;
        fa::mla_item(C.Q, C.KV, C.KR, C.OAB, bh >> 3, bh & 7, 63 - sidx, vl, lane_id());
        fa::mla_item(C.Q, C.KV, C.KR, C.OAB, bh >> 3, bh & 7, sidx, vl, lane_id());
    }
    for (int pid = C.gw; pid < BATCH * NH * 32; pid += C.ngw) {
        const int bh = pid >> 5, r = (pid >> 3) & 3, sidx = pid & 7;
        fa::dil_item(C.QKVD, C.OAB, bh >> 3, bh & 7, r, 15 - sidx, vl, lane_id());
        fa::dil_item(C.QKVD, C.OAB, bh >> 3, bh & 7, r, sidx, vl, lane_id());
    }
}

#ifndef F_IN
#define F_IN 1
#endif
#ifndef F_UP
#define F_UP 1
#endif
#ifndef F_MIX
#define F_MIX 1
#endif
#ifndef F_OUT
#define F_OUT 1
#endif
#ifndef F_FF1
#define F_FF1 1
#endif
#ifndef F_FF2
#define F_FF2 1
#endif
#ifndef F_ATTN
#define F_ATTN 1
#endif
#ifndef F_PROBE
#define F_PROBE 0
#endif
__device__ __forceinline__ void kr_rope(Ctx& C) {
    for (long idx = gt_id(); idx < (long)M * 16; idx += C.ngt) {
        const int m = (int)(idx >> 4), j = (int)(idx & 15), pos = m % SEQ;
        const float c = C.ROPET[2 * (pos * 16 + j)], s = C.ROPET[2 * (pos * 16 + j) + 1];
        const float t1 = bf2f(C.PS[(size_t)m * PSW + 640 + j]), t2 = bf2f(C.PS[(size_t)m * PSW + 656 + j]);
        C.KR[(size_t)m * 32 + j] = (bf16_t)f2bf(t1 * c - t2 * s); C.KR[(size_t)m * 32 + 16 + j] = (bf16_t)f2bf(t1 * s + t2 * c);
    }
}

#define XB_TMO      128
#define XB_XCNT(j)  (256  + 64 * (j))
#define XB_XSUB(j)  (1280 + 64 * (j))
#define XB_XGEN(j)  (2304 + 64 * (j))
#define XB_TOP      3328
#define XB_TOPGEN   3392
#define XCD_BAR_WORDS 3456
#define XB_SPIN_CAP (1u << 22)
__device__ __forceinline__ unsigned xb_ld(unsigned* p)              { return __hip_atomic_load(p, __ATOMIC_RELAXED, __HIP_MEMORY_SCOPE_AGENT); }
__device__ __forceinline__ unsigned xb_add(unsigned* p, unsigned v) { return __hip_atomic_fetch_add(p, v, __ATOMIC_RELAXED, __HIP_MEMORY_SCOPE_AGENT); }
__device__ __forceinline__ unsigned xb_xcc_id() { return (unsigned)__builtin_amdgcn_s_getreg((3 << 11) | 20) & 0xFu; }
#define XB_SPIN(cond, bar) do { unsigned _sp = 0; while (cond) { __builtin_amdgcn_s_sleep(1); \
    if ((++_sp & 255u) == 0u) { if (xb_ld(&(bar)[XB_TMO])) break; if (_sp > XB_SPIN_CAP) { atomicAdd(&(bar)[XB_TMO], 1u); break; } } } } while (0)
struct XcdBarrier { unsigned* bar; unsigned x; volatile LAS unsigned* st; };
__device__ __forceinline__ XcdBarrier xcd_barrier_post(unsigned* bar, volatile LAS unsigned* st) {
    XcdBarrier b; b.bar = bar; b.x = xb_xcc_id(); b.st = st;
    if (threadIdx.x == 0) (void)xb_add(&bar[XB_XCNT(b.x)], 1u);
    return b;
}
__device__ __forceinline__ void xcd_barrier_complete(unsigned* bar, unsigned x, unsigned& nloc, unsigned& nx) {
    const unsigned G = gridDim.x * gridDim.y * gridDim.z;
    unsigned sum, cnt, mine, sp = 0u;
    for (;;) {
        sum = 0u; cnt = 0u; mine = 0u;
#pragma unroll
        for (unsigned j = 0; j < 16; ++j) { const unsigned c = xb_ld(&bar[XB_XCNT(j)]); sum += c; cnt += (c > 0u) ? 1u : 0u; mine = (j == x) ? c : mine; }
        if (sum == G) break;
        __builtin_amdgcn_s_sleep(1);
        if ((++sp & 255u) == 0u) { if (xb_ld(&bar[XB_TMO])) break; if (sp > XB_SPIN_CAP) { atomicAdd(&bar[XB_TMO], 1u); break; } }
    }
    nloc = mine > 0u ? mine : 1u; nx = cnt > 0u ? cnt : 1u;
}
__device__ __forceinline__ void xcd_barrier(const XcdBarrier& b) {
    asm volatile("s_waitcnt vmcnt(0)" ::: "memory");
    __syncthreads();
    if (threadIdx.x == 0) {
        unsigned* bar = b.bar;
        __builtin_amdgcn_s_waitcnt(0);
        unsigned nloc = b.st[0], nx = b.st[1];
        if (nloc == 0u) { xcd_barrier_complete(bar, b.x, nloc, nx); b.st[0] = nloc; b.st[1] = nx; }
        const unsigned old = xb_add(&bar[XB_XSUB(b.x)], 1u);
        const unsigned gen = old / nloc;
        if (old + 1u == (gen + 1u) * nloc) {
            __builtin_amdgcn_fence(__ATOMIC_RELEASE, "agent");
            asm volatile("s_waitcnt vmcnt(0)" ::: "memory");
            const unsigned og = xb_add(&bar[XB_TOP], 1u);
            const unsigned tg = og / nx;
            if (og + 1u == (tg + 1u) * nx) xb_add(&bar[XB_TOPGEN], 1u);
            else XB_SPIN(xb_ld(&bar[XB_TOPGEN]) == tg, bar);
            __builtin_amdgcn_fence(__ATOMIC_ACQUIRE, "agent");
            xb_add(&bar[XB_XGEN(b.x)], 1u);
            asm volatile("s_waitcnt vmcnt(0)" ::: "memory");
        } else {
            XB_SPIN(xb_ld(&bar[XB_XGEN(b.x)]) == gen, bar);
            __builtin_amdgcn_fence(__ATOMIC_ACQUIRE, "agent");
            asm volatile("s_waitcnt vmcnt(0)" ::: "memory");
        }
    }
    __syncthreads();
}

constexpr int NTHREADS = 512;
constexpr int LDS_BYTES = 147456;
constexpr int NPHASES = 12;

__global__ void __launch_bounds__(NTHREADS, 2) fwd_megakernel(Args args) {
    extern __shared__ __attribute__((aligned(16))) unsigned char lds_raw[];
    LAS unsigned char* lds = (LAS unsigned char*)lds_raw;
    cg::grid_group grid = cg::this_grid();
    Ctx C;
    C.wave = __builtin_amdgcn_readfirstlane((int)threadIdx.x >> 6);
    C.gw = blockIdx.x * (NTHREADS / 64) + C.wave; C.ngw = gridDim.x * (NTHREADS / 64);
    C.ngt = (long)gridDim.x * NTHREADS;
    C.x = args.in[0]; C.w_in = args.in[1]; C.b_gate = args.in[2]; C.g_q_a = args.in[3]; C.w_uq = args.in[4]; C.g_kv_a = args.in[5]; C.w_ukv = args.in[6];
    C.w_o_mla = args.in[7]; C.w_o_dil = args.in[8]; C.w_out = args.in[9]; C.ln1_g = args.in[10]; C.ln1_b = args.in[11]; C.w_ff1 = args.in[12]; C.w_ff2 = args.in[13];
    C.ln2_g = args.in[14]; C.ln2_b = args.in[15]; C.out = args.out; C.ws = args.ws;
    unsigned char* ws = args.ws;
    C.WIN = (bf16_t*)(ws + WS_WIN); C.WUQ = (bf16_t*)(ws + WS_WUQ); C.WUKV = (bf16_t*)(ws + WS_WUKV); C.WOAB = (bf16_t*)(ws + WS_WOAB); C.WOUT = (bf16_t*)(ws + WS_WOUT);
    C.WFF1 = (bf16_t*)(ws + WS_WFF1); C.WFF2 = (bf16_t*)(ws + WS_WFF2); C.ROPET = (float*)(ws + WS_ROPE); C.SUMSQ = (float*)(ws + WS_SUMSQ);
    C.PS = (bf16_t*)(ws + WS_PS); C.QKVD = (bf16_t*)(ws + WS_QKVD); C.GATES = (bf16_t*)(ws + WS_GATES); C.XB = (bf16_t*)(ws + WS_XB); C.Q = C.XB; C.MIXIN = C.XB;
    C.KV = (bf16_t*)(ws + WS_KV); C.T = C.KV; C.HB = C.KV; C.OAB = (bf16_t*)(ws + WS_OAB); C.KR = (bf16_t*)(ws + WS_KR); C.HID = (bf16_t*)(ws + WS_HID);

    const int G = gridDim.x, cu = blockIdx.x;
    volatile LAS unsigned* misc = (volatile LAS unsigned*)(lds + 131072 + 320);
    if (threadIdx.x < 16) misc[threadIdx.x] = 0u;
    __syncthreads();
    XcdBarrier xbar = xcd_barrier_post((unsigned*)(args.ws) + 1024, misc + 8);
#if F_PROBE == 5
#define SYNC() do { xcd_barrier(xbar); xcd_barrier(xbar); } while (0)
#else
#define SYNC() xcd_barrier(xbar)
#endif
    p0_prologue(C, lds);
#if F_PROBE == 6
    p0_prologue(C, lds);
#endif
    grid.sync();
#if F_IN
    { pg8::Gemm g{C.XB, C.WIN, DM, DM, DM}; pg8::StaticOrder S; S.init(M, NIN, G, cu);
      pg8::EpiIn E{C.PS, C.QKVD, C.GATES, C.b_gate, C.SUMSQ, true};
      pg8::gemm_phase<pg8::EpiIn, pg8::StaticOrder, true>(lds, g, S, E);
#if F_PROBE == 4
      pg8::EpiIn E2{C.PS, C.QKVD, C.GATES, C.b_gate, C.SUMSQ, false};
      pg8::gemm_phase<pg8::EpiIn, pg8::StaticOrder, true>(lds, g, S, E2);
#endif
    }
    SYNC();
#else
    p1_naive(C); SYNC();
#endif
#if F_UP
#ifndef T_NOQ
    { pg8::Gemm g{C.PS, C.WUQ, QLORA, PSW, QLORA}; pg8::StaticOrder S; S.init(M, 768, G, cu);
      pg8::EpiQ E{C.Q, C.SUMSQ, C.ROPET};
      pg8::gemm_phase<pg8::EpiQ, pg8::StaticOrder, true>(lds, g, S, E); }
#endif
#ifndef T_NOKV
    { pg8::Gemm g{C.PS + QLORA, C.WUKV, KVLORA, PSW, KVLORA}; pg8::StaticOrder S; S.init(M, 1024, G, cu);
      pg8::EpiKV E{C.KV, C.SUMSQ};
      pg8::gemm_phase<pg8::EpiKV, pg8::StaticOrder, true>(lds, g, S, E); }
#endif
    kr_rope(C);
#if F_PROBE == 7
    { pg8::Gemm g{C.PS, C.WUQ, QLORA, PSW, QLORA}; pg8::StaticOrder S; S.init(M, 768, G, cu);
      pg8::EpiQ E{C.Q, C.SUMSQ, C.ROPET};
      pg8::gemm_phase<pg8::EpiQ, pg8::StaticOrder, true>(lds, g, S, E); }
    { pg8::Gemm g{C.PS + QLORA, C.WUKV, KVLORA, PSW, KVLORA}; pg8::StaticOrder S; S.init(M, 1024, G, cu);
      pg8::EpiKV E{C.KV, C.SUMSQ};
      pg8::gemm_phase<pg8::EpiKV, pg8::StaticOrder, true>(lds, g, S, E); }
    kr_rope(C);
#endif
    SYNC();
#else
    p2_naive(C); SYNC();
    p2b_naive_qrope(C); SYNC();
#endif
#if F_ATTN == 1
    p3_fast(C, lds);
#if F_PROBE == 1
    p3_fast_mla_only(C, lds);
#elif F_PROBE == 2
    p3_fast_dil_only(C, lds);
#endif
#elif F_ATTN == 2
    p3_naive_mla(C); p3_fast_dil_only(C, lds);
#elif F_ATTN == 3
    p3_fast_mla_only(C, lds); p3_naive_dil(C);
#else
    p3_naive_mla(C); p3_naive_dil(C);
#endif
    SYNC();
#if F_MIX
    { pg8::Gemm g{C.OAB, C.WOAB, 512, 512, 512}; pg8::PairOrder S; S.init(M, 1024, G, cu);
      pg8::EpiMix E{C.GATES, C.T, C.MIXIN};
      pg8::gemm_phase<pg8::EpiMix, pg8::PairOrder, true>(lds, g, S, E);
#if F_PROBE == 8
      pg8::gemm_phase<pg8::EpiMix, pg8::PairOrder, true>(lds, g, S, E);
#endif
    }
    SYNC();
#else
    p4_naive(C); SYNC();
    p4b_naive(C); SYNC();
#endif
#if F_OUT
    { pg8::Gemm g{C.MIXIN, C.WOUT, DM, DM, DM}; pg8::StaticOrder S; S.init(M, DM, G, cu);
      pg8::EpiRes E{C.x, C.out};
      pg8::gemm_phase<pg8::EpiRes, pg8::StaticOrder, true>(lds, g, S, E);
#if F_PROBE == 9
      pg8::gemm_phase<pg8::EpiRes, pg8::StaticOrder, true>(lds, g, S, E);
#endif
    }
    SYNC();
#else
    p5_naive(C); SYNC();
#endif
#if F_PROBE == 10
    ln_rows(C, C.ln1_g, C.ln1_b, C.PS, (float*)(C.ws + 100 * MiB));
#endif
    ln_rows(C, C.ln1_g, C.ln1_b, C.HB); SYNC();
#if F_FF1
    { pg8::Gemm g{C.HB, C.WFF1, DM, DM, DM}; pg8::StaticOrder S; S.init(M, DFF, G, cu);
      pg8::EpiSqRelu E{C.HID};
      pg8::gemm_phase<pg8::EpiSqRelu, pg8::StaticOrder, true>(lds, g, S, E);
#if F_PROBE == 3
      pg8::gemm_phase<pg8::EpiSqRelu, pg8::StaticOrder, true>(lds, g, S, E);
#endif
    }
    SYNC();
#else
    p7_naive(C); SYNC();
#endif
#if F_FF2
    { pg8::Gemm g{C.HID, C.WFF2, DFF, DFF, DFF}; pg8::StaticOrder S; S.init(M, DM, G, cu);
      pg8::EpiRes E{C.out, C.out};
      pg8::gemm_phase<pg8::EpiRes, pg8::StaticOrder, true>(lds, g, S, E); }
    SYNC();
#else
    p8_naive(C); SYNC();
#endif
#if F_PROBE == 10
    ln_rows(C, C.ln2_g, C.ln2_b, nullptr, (float*)(C.ws + 300 * MiB));
#endif
    ln_rows(C, C.ln2_g, C.ln2_b, nullptr);
#undef SYNC
}

extern "C" void kernel_launch(void* const* d_in, const int* in_sizes, int n_in, void* d_out, int out_size, void* d_ws, size_t ws_size, hipStream_t stream) {
    static int grid = 0;
    if (grid == 0) {
        if (n_in != 16 || in_sizes[0] != M * DM || out_size != M * DM || ws_size < WS_END) {
            fprintf(stderr, "kernel_launch: unexpected shapes: n_in %d in0 %d out %d ws %zu (need >= %zu)\n", n_in, n_in > 0 ? in_sizes[0] : -1, out_size, ws_size, (size_t)WS_END);
            grid = -1; return;
        }
        int dev = 0, cus = 0, per_cu = 0;
        (void)hipGetDevice(&dev);
        (void)hipDeviceGetAttribute(&cus, hipDeviceAttributeMultiprocessorCount, dev);
        (void)hipFuncSetAttribute((const void*)fwd_megakernel, hipFuncAttributeMaxDynamicSharedMemorySize, LDS_BYTES);
        (void)hipOccupancyMaxActiveBlocksPerMultiprocessor(&per_cu, (const void*)fwd_megakernel, NTHREADS, LDS_BYTES);
        if (per_cu < 1) { fprintf(stderr, "kernel_launch: occupancy query returned %d\n", per_cu); per_cu = 1; }
        (void)hipGetLastError();
        grid = cus * per_cu;
    }
    if (grid < 0) return;
    if (hipMemsetAsync(d_ws, 0, 65536, stream) != hipSuccess) { fprintf(stderr, "kernel_launch: memset of the barrier words failed\n"); return; }
    Args a{};
    for (int i = 0; i < 16; ++i) a.in[i] = (const float*)d_in[i];
    a.out = (float*)d_out; a.ws = (unsigned char*)d_ws; a.ph_lo = 0; a.ph_hi = NPHASES;
    void* kargs[] = {&a};
    hipError_t e = hipLaunchCooperativeKernel((const void*)fwd_megakernel, dim3(grid), dim3(NTHREADS), kargs, LDS_BYTES, stream);
    if (e != hipSuccess) fprintf(stderr, "cooperative launch failed: %s (grid %d)\n", hipGetErrorString(e), grid);
}
```

```cpp
#include <hip/hip_runtime.h>
#include <hip/hip_cooperative_groups.h>
#include <cstdio>
#include <cstdint>
namespace cg = cooperative_groups;

#define LAS __attribute__((address_space(3)))
typedef unsigned short bf16_t;
typedef float f32x4 __attribute__((ext_vector_type(4)));
typedef unsigned u32x4 __attribute__((ext_vector_type(4)));
typedef unsigned u32x2 __attribute__((ext_vector_type(2)));

constexpr int BATCH = 16, SEQ = 2048, DM = 1024, M = BATCH * SEQ;
constexpr int NH = 8;
constexpr int QLORA = 384, KVLORA = 256, ROPE = 32, NOPE = 64, VD = 64, QK = 96;
constexpr int NIN = 4352;
constexpr int PSW = 768, QKVDW = 1536, GATEW = 2048;
constexpr int DFF = 4096;
constexpr float LN_EPS = 1e-5f, RMS_EPS = 1e-6f;
constexpr float ALPHA = 1.189207115002721f;
constexpr float LOG2E = 1.4426950408889634f;
constexpr float QSCALE = 0.10206207261596577f * LOG2E;

constexpr size_t MiB = 1u << 20;
constexpr size_t WS_WIN = 2 * MiB;
constexpr size_t WS_WUQ = 11 * MiB;
constexpr size_t WS_WUKV = 12 * MiB;
constexpr size_t WS_WOAB = 13 * MiB;
constexpr size_t WS_WOUT = 15 * MiB;
constexpr size_t WS_WFF1 = 17 * MiB;
constexpr size_t WS_WFF2 = 25 * MiB;
constexpr size_t WS_ROPE = 33 * MiB;
constexpr size_t WS_SUMSQ = 33 * MiB + 512 * 1024;
constexpr size_t WS_PS = 34 * MiB;
constexpr size_t WS_QKVD = 82 * MiB;
constexpr size_t WS_GATES = 178 * MiB;
constexpr size_t WS_XB = 306 * MiB;
constexpr size_t WS_KV = 370 * MiB;
constexpr size_t WS_OAB = 434 * MiB;
constexpr size_t WS_KR = 498 * MiB;
constexpr size_t WS_HID = 34 * MiB;
constexpr size_t WS_END = 500 * MiB;

__device__ __forceinline__ float bf2f(bf16_t v) { return __uint_as_float((unsigned)v << 16); }
__device__ __forceinline__ unsigned f2bf(float f) { unsigned u = __float_as_uint(f); return (u + 0x7fffu + ((u >> 16) & 1u)) >> 16; }
__device__ __forceinline__ unsigned pk2(float lo, float hi) { return f2bf(lo) | (f2bf(hi) << 16); }
__device__ __forceinline__ float lo16(unsigned u) { return __uint_as_float(u << 16); }
__device__ __forceinline__ float hi16(unsigned u) { return __uint_as_float(u & 0xffff0000u); }
__device__ __forceinline__ float wave_sum(float v) {
#pragma unroll
    for (int o = 1; o < 64; o <<= 1) v += __shfl_xor(v, o);
    return v;
}

struct Args { const float* in[16]; float* out; unsigned char* ws; int ph_lo, ph_hi; };

__device__ __forceinline__ int lane_id() { int t = threadIdx.x; asm volatile("" : "+v"(t)); return t & 63; }
__device__ __forceinline__ long gt_id() { return (long)blockIdx.x * 512 + threadIdx.x; }
struct Ctx {
    int wave, gw, ngw; long ngt;
    const float *x, *w_in, *b_gate, *g_q_a, *w_uq, *g_kv_a, *w_ukv, *w_o_mla, *w_o_dil, *w_out, *ln1_g, *ln1_b, *w_ff1, *w_ff2, *ln2_g, *ln2_b;
    float* out; unsigned char* ws;
    bf16_t *WIN, *WUQ, *WUKV, *WOAB, *WOUT, *WFF1, *WFF2, *PS, *QKVD, *GATES, *XB, *Q, *MIXIN, *KV, *T, *HB, *OAB, *KR, *HID;
    float* ROPET; float* SUMSQ;
};

__device__ __forceinline__ void transpose_item(const float* W, int Nsrc, int src_n0, const float* kscale, bf16_t* WT, int K, int dst_n0, int k0, LAS float* scr, int lane) {
#pragma unroll 8
    for (int i = 0; i < 32; ++i) {
        const int kk = 2 * i + (lane >> 5);
        float v = 0.f;
        if (src_n0 >= 0) { v = W[(size_t)(k0 + kk) * Nsrc + src_n0 + (lane & 31)]; if (kscale) v *= kscale[k0 + kk]; }
        scr[kk * 33 + (lane & 31)] = v;
    }
    asm volatile("s_waitcnt lgkmcnt(0)" ::: "memory");
    const int c = lane & 7;
#pragma unroll
    for (int j = 0; j < 4; ++j) {
        const int n = (lane >> 3) + 8 * j; const LAS float* s = scr + (8 * c) * 33 + n;
        u32x4 o; o.x = pk2(s[0 * 33], s[1 * 33]); o.y = pk2(s[2 * 33], s[3 * 33]); o.z = pk2(s[4 * 33], s[5 * 33]); o.w = pk2(s[6 * 33], s[7 * 33]);
        *(u32x4*)(WT + (size_t)(dst_n0 + n) * K + k0 + 8 * c) = o;
    }
    asm volatile("s_waitcnt lgkmcnt(0)" ::: "memory");
}
__device__ __forceinline__ bool tr_matrix(int& r, const float* W, int K, int Nsrc, int Ndst, bool in_map, const float* kscale, bf16_t* WT, int dst_row_off, LAS float* scr, int lane) {
    const int nblk = Ndst / 32, items = (K / 64) * nblk;
    if (r >= items) { r -= items; return false; }
    const int kb = r / nblk, nb = r % nblk, n0 = nb * 32;
    int src = n0;
    if (in_map) src = (n0 < 672) ? n0 : (n0 < 768 ? -1 : n0 - 96);
    transpose_item(W, Nsrc, src, kscale, WT, K, dst_row_off + n0, kb * 64, scr, lane);
    return true;
}
__device__ __forceinline__ void p0_prologue(Ctx& C, LAS unsigned char* lds) {
    LAS float* scr = (LAS float*)(lds + C.wave * 16384);
    constexpr int NITEMS = 16 * 136 + 6 * 24 + 4 * 32 + 8 * 32 + 8 * 32 + 16 * 32 + 16 * 128 + 64 * 32;
    for (int it = C.gw; it < NITEMS; it += C.ngw) {
        int r = it;
        if (tr_matrix(r, C.w_in, 1024, 4256, NIN, true, nullptr, C.WIN, 0, scr, lane_id())) continue;
        if (tr_matrix(r, C.w_uq, QLORA, 768, 768, false, C.g_q_a, C.WUQ, 0, scr, lane_id())) continue;
        if (tr_matrix(r, C.w_ukv, KVLORA, 1024, 1024, false, C.g_kv_a, C.WUKV, 0, scr, lane_id())) continue;
        if (tr_matrix(r, C.w_o_mla, 512, 1024, 1024, false, nullptr, C.WOAB, 0, scr, lane_id())) continue;
        if (tr_matrix(r, C.w_o_dil, 512, 1024, 1024, false, nullptr, C.WOAB, 1024, scr, lane_id())) continue;
        if (tr_matrix(r, C.w_out, 1024, 1024, 1024, false, nullptr, C.WOUT, 0, scr, lane_id())) continue;
        if (tr_matrix(r, C.w_ff1, 1024, 4096, 4096, false, nullptr, C.WFF1, 0, scr, lane_id())) continue;
        tr_matrix(r, C.w_ff2, 4096, 1024, 1024, false, nullptr, C.WFF2, 0, scr, lane_id());
    }
    {
        const f32x4* xs = (const f32x4*)C.x; u32x2* xd = (u32x2*)C.XB; const long n4 = (long)M * DM / 4;
        for (long i = gt_id(); i < n4; i += 4 * C.ngt) {
            f32x4 v[4];
#pragma unroll
            for (int j = 0; j < 4; ++j) if (i + j * C.ngt < n4) v[j] = xs[i + j * C.ngt];
#pragma unroll
            for (int j = 0; j < 4; ++j) if (i + j * C.ngt < n4) { u32x2 o; o.x = pk2(v[j].x, v[j].y); o.y = pk2(v[j].z, v[j].w); xd[i + j * C.ngt] = o; }
        }
    }
    for (long i = gt_id(); i < SEQ * 16; i += C.ngt) {
        const int pos = (int)(i >> 4), j = (int)(i & 15);
        const float inv = powf(10000.0f, -(float)j / 16.0f); const float ang = (float)pos * inv;
        C.ROPET[2 * i] = cosf(ang); C.ROPET[2 * i + 1] = sinf(ang);
    }
    for (long i = gt_id(); i < (long)M * 2; i += C.ngt) C.SUMSQ[i] = 0.f;
}

template <class F> __device__ __forceinline__ void naive_gemm(Ctx& C, const bf16_t* A, int lda, const bf16_t* Bt, int ldb, int Mr, int N, int K, F epi) {
    const int n4 = N / 4; const long total = (long)Mr * n4;
    for (long idx = gt_id(); idx < total; idx += C.ngt) {
        const int m = (int)(idx / n4), n0 = (int)(idx % n4) * 4;
        float a0 = 0.f, a1 = 0.f, a2 = 0.f, a3 = 0.f, ss = 0.f;
        const bf16_t* ar = A + (size_t)m * lda; const bf16_t* br = Bt + (size_t)n0 * ldb;
        for (int k = 0; k < K; k += 8) {
            const u32x4 av = *(const u32x4*)(ar + k);
            const u32x4 b0 = *(const u32x4*)(br + k), b1 = *(const u32x4*)(br + ldb + k), b2 = *(const u32x4*)(br + 2 * ldb + k), b3 = *(const u32x4*)(br + 3 * ldb + k);
#pragma unroll
            for (int e = 0; e < 4; ++e) {
                const float al = lo16(av[e]), ah = hi16(av[e]);
                ss += al * al + ah * ah;
                a0 += al * lo16(b0[e]) + ah * hi16(b0[e]); a1 += al * lo16(b1[e]) + ah * hi16(b1[e]);
                a2 += al * lo16(b2[e]) + ah * hi16(b2[e]); a3 += al * lo16(b3[e]) + ah * hi16(b3[e]);
            }
        }
        epi(m, n0, a0, a1, a2, a3, ss);
    }
}
__device__ __forceinline__ float sigmoidf_(float v) { return 1.0f / (1.0f + __expf(-v)); }

__device__ __forceinline__ void p1_naive(Ctx& C) {
    naive_gemm(C, C.XB, DM, C.WIN, DM, M, NIN, DM, [&](int m, int n0, float a0, float a1, float a2, float a3, float) {
        u32x2 o;
        if (n0 < PSW) { o.x = pk2(a0, a1); o.y = pk2(a2, a3); *(u32x2*)(C.PS + (size_t)m * PSW + n0) = o; }
        else if (n0 < PSW + QKVDW) { o.x = pk2(a0, a1); o.y = pk2(a2, a3); *(u32x2*)(C.QKVD + (size_t)m * QKVDW + (n0 - PSW)) = o; }
        else { const int g = n0 - PSW - QKVDW; const f32x4 b = *(const f32x4*)(C.b_gate + g);
            o.x = pk2(sigmoidf_(a0 + b.x), sigmoidf_(a1 + b.y)); o.y = pk2(sigmoidf_(a2 + b.z), sigmoidf_(a3 + b.w)); *(u32x2*)(C.GATES + (size_t)m * GATEW + g) = o; }
    });
}
__device__ __forceinline__ void p2_naive(Ctx& C) {
    naive_gemm(C, C.PS, PSW, C.WUQ, QLORA, M, 768, QLORA, [&](int m, int n0, float a0, float a1, float a2, float a3, float ss) {
        const float rs = rsqrtf(ss * (1.0f / QLORA) + RMS_EPS) * QSCALE;
        u32x2 o; o.x = pk2(a0 * rs, a1 * rs); o.y = pk2(a2 * rs, a3 * rs); *(u32x2*)(C.Q + (size_t)m * 768 + n0) = o;
    });
    naive_gemm(C, C.PS + QLORA, PSW, C.WUKV, KVLORA, M, 1024, KVLORA, [&](int m, int n0, float a0, float a1, float a2, float a3, float ss) {
        const float rs = rsqrtf(ss * (1.0f / KVLORA) + RMS_EPS);
        u32x2 o; o.x = pk2(a0 * rs, a1 * rs); o.y = pk2(a2 * rs, a3 * rs); *(u32x2*)(C.KV + (size_t)m * 1024 + n0) = o;
    });
    for (long idx = gt_id(); idx < (long)M * 16; idx += C.ngt) {
        const int m = (int)(idx >> 4), j = (int)(idx & 15), pos = m % SEQ;
        const float c = C.ROPET[2 * (pos * 16 + j)], s = C.ROPET[2 * (pos * 16 + j) + 1];
        const float t1 = bf2f(C.PS[(size_t)m * PSW + 640 + j]), t2 = bf2f(C.PS[(size_t)m * PSW + 656 + j]);
        C.KR[(size_t)m * 32 + j] = (bf16_t)f2bf(t1 * c - t2 * s); C.KR[(size_t)m * 32 + 16 + j] = (bf16_t)f2bf(t1 * s + t2 * c);
    }
}
__device__ __forceinline__ void p2b_naive_qrope(Ctx& C) {
    for (long idx = gt_id(); idx < (long)M * NH * 16; idx += C.ngt) {
        const int j = (int)(idx & 15), h = (int)((idx >> 4) & 7), m = (int)(idx >> 7), pos = m % SEQ;
        const float c = C.ROPET[2 * (pos * 16 + j)], s = C.ROPET[2 * (pos * 16 + j) + 1];
        bf16_t* p = C.Q + (size_t)m * 768 + h * 96 + 64 + j;
        const float t1 = bf2f(p[0]), t2 = bf2f(p[16]);
        p[0] = (bf16_t)f2bf(t1 * c - t2 * s); p[16] = (bf16_t)f2bf(t1 * s + t2 * c);
    }
}

__device__ __forceinline__ void p3_naive_mla(Ctx& C) {
    for (long idx = gt_id(); idx < (long)BATCH * NH * SEQ; idx += C.ngt) {
        const int q = (int)(idx % SEQ), h = (int)((idx / SEQ) % NH), b = (int)(idx / (SEQ * NH));
        const size_t m = (size_t)b * SEQ + q;
        u32x4 qv[12];
#pragma unroll
        for (int i = 0; i < 12; ++i) qv[i] = *(const u32x4*)(C.Q + m * 768 + h * 96 + i * 8);
        float o[64];
#pragma unroll
        for (int d = 0; d < 64; ++d) o[d] = 0.f;
        float mx = -1e30f, l = 0.f;
        const int kmax = __builtin_amdgcn_readfirstlane(q | 63);
        for (int k = 0; k <= kmax; ++k) {
            const size_t mk = (size_t)b * SEQ + k;
            const bf16_t* kp = C.KV + mk * 1024 + h * 128; const bf16_t* rp = C.KR + mk * 32;
            float s = 0.f;
#pragma unroll
            for (int i = 0; i < 8; ++i) { const u32x4 kv = *(const u32x4*)(kp + i * 8);
#pragma unroll
                for (int e = 0; e < 4; ++e) s += lo16(qv[i][e]) * lo16(kv[e]) + hi16(qv[i][e]) * hi16(kv[e]); }
#pragma unroll
            for (int i = 0; i < 4; ++i) { const u32x4 kv = *(const u32x4*)(rp + i * 8);
#pragma unroll
                for (int e = 0; e < 4; ++e) s += lo16(qv[8 + i][e]) * lo16(kv[e]) + hi16(qv[8 + i][e]) * hi16(kv[e]); }
            if (k <= q) {
                const float mn = fmaxf(mx, s), f = exp2f(mx - mn), p = exp2f(s - mn);
                l = l * f + p; mx = mn;
#pragma unroll
                for (int i = 0; i < 8; ++i) { const u32x4 vv = *(const u32x4*)(kp + 64 + i * 8);
#pragma unroll
                    for (int e = 0; e < 4; ++e) { o[i * 8 + 2 * e] = o[i * 8 + 2 * e] * f + p * lo16(vv[e]); o[i * 8 + 2 * e + 1] = o[i * 8 + 2 * e + 1] * f + p * hi16(vv[e]); } }
            }
        }
        const float il = 1.0f / l;
        bf16_t* op = C.OAB + m * 512 + h * 64;
#pragma unroll
        for (int i = 0; i < 8; ++i) { u32x4 w; w.x = pk2(o[i * 8] * il, o[i * 8 + 1] * il); w.y = pk2(o[i * 8 + 2] * il, o[i * 8 + 3] * il); w.z = pk2(o[i * 8 + 4] * il, o[i * 8 + 5] * il); w.w = pk2(o[i * 8 + 6] * il, o[i * 8 + 7] * il); *(u32x4*)(op + i * 8) = w; }
    }
}
__device__ __forceinline__ void p3_naive_dil(Ctx& C) {
    for (long idx = gt_id(); idx < (long)BATCH * NH * SEQ; idx += C.ngt) {
        const int t = (int)(idx % SEQ), h = (int)((idx / SEQ) % NH), b = (int)(idx / (SEQ * NH));
        const size_t m = (size_t)b * SEQ + t;
        const float slope = exp2f(-(float)(h + 1));
        u32x4 qv[8];
#pragma unroll
        for (int i = 0; i < 8; ++i) qv[i] = *(const u32x4*)(C.QKVD + m * QKVDW + h * 64 + i * 8);
        float num[64];
#pragma unroll
        for (int d = 0; d < 64; ++d) num[d] = 0.f;
        float m_all = -1e30f, tot = 0.f;
        for (int p = 0; p < 3; ++p) {
            const int dil = (p == 0) ? 1 : (p == 1 ? 4 : 16);
            float o[64];
#pragma unroll
            for (int d = 0; d < 64; ++d) o[d] = 0.f;
            float mx = -1e30f, l = 0.f;
            for (int j = 0; j <= 128; ++j) {
                const int tk = t - j * dil; if (tk < 0) break;
                const bf16_t* kp = C.QKVD + ((size_t)b * SEQ + tk) * QKVDW + 512 + h * 64;
                float s = 0.f;
#pragma unroll
                for (int i = 0; i < 8; ++i) { const u32x4 kv = *(const u32x4*)(kp + i * 8);
#pragma unroll
                    for (int e = 0; e < 4; ++e) s += lo16(qv[i][e]) * lo16(kv[e]) + hi16(qv[i][e]) * hi16(kv[e]); }
                s = s * 0.125f - slope * (float)(dil * j);
                const float mn = fmaxf(mx, s), f = __expf(mx - mn), pe = __expf(s - mn);
                l = l * f + pe; mx = mn;
#pragma unroll
                for (int i = 0; i < 8; ++i) { const u32x4 vv = *(const u32x4*)(kp + 512 + i * 8);
#pragma unroll
                    for (int e = 0; e < 4; ++e) { o[i * 8 + 2 * e] = o[i * 8 + 2 * e] * f + pe * lo16(vv[e]); o[i * 8 + 2 * e + 1] = o[i * 8 + 2 * e + 1] * f + pe * hi16(vv[e]); } }
            }
            const float mn = fmaxf(m_all, mx), fa = __expf(m_all - mn), fb = __expf(mx - mn);
            tot = tot * fa + l * fb; m_all = mn;
#pragma unroll
            for (int d = 0; d < 64; ++d) num[d] = num[d] * fa + o[d] * fb;
        }
        const float it = 1.0f / tot;
        bf16_t* op = C.OAB + ((size_t)M + m) * 512 + h * 64;
#pragma unroll
        for (int i = 0; i < 8; ++i) { u32x4 w; w.x = pk2(num[i * 8] * it, num[i * 8 + 1] * it); w.y = pk2(num[i * 8 + 2] * it, num[i * 8 + 3] * it); w.z = pk2(num[i * 8 + 4] * it, num[i * 8 + 5] * it); w.w = pk2(num[i * 8 + 6] * it, num[i * 8 + 7] * it); *(u32x4*)(op + i * 8) = w; }
    }
}
__device__ __forceinline__ void p4_naive(Ctx& C) {
    naive_gemm(C, C.OAB, 512, C.WOAB, 512, M, 1024, 512, [&](int m, int n0, float a0, float a1, float a2, float a3, float) {
        const u32x2 g = *(const u32x2*)(C.GATES + (size_t)m * GATEW + n0);
        u32x2 o; o.x = pk2(a0 * lo16(g.x), a1 * hi16(g.x)); o.y = pk2(a2 * lo16(g.y), a3 * hi16(g.y)); *(u32x2*)(C.T + (size_t)m * 1024 + n0) = o;
    });
}
__device__ __forceinline__ void p4b_naive(Ctx& C) {
    naive_gemm(C, C.OAB + (size_t)M * 512, 512, C.WOAB + (size_t)1024 * 512, 512, M, 1024, 512, [&](int m, int n0, float a0, float a1, float a2, float a3, float) {
        const u32x2 g = *(const u32x2*)(C.GATES + (size_t)m * GATEW + 1024 + n0); const u32x2 t = *(const u32x2*)(C.T + (size_t)m * 1024 + n0);
        u32x2 o; o.x = pk2(lo16(t.x) + a0 * lo16(g.x), hi16(t.x) + a1 * hi16(g.x)); o.y = pk2(lo16(t.y) + a2 * lo16(g.y), hi16(t.y) + a3 * hi16(g.y)); *(u32x2*)(C.MIXIN + (size_t)m * 1024 + n0) = o;
    });
}
__device__ __forceinline__ void p5_naive(Ctx& C) {
    naive_gemm(C, C.MIXIN, 1024, C.WOUT, 1024, M, 1024, 1024, [&](int m, int n0, float a0, float a1, float a2, float a3, float) {
        const f32x4 xv = *(const f32x4*)(C.x + (size_t)m * DM + n0);
        *(f32x4*)(C.out + (size_t)m * DM + n0) = (f32x4){ALPHA * xv.x + a0, ALPHA * xv.y + a1, ALPHA * xv.z + a2, ALPHA * xv.w + a3};
    });
}
__device__ __forceinline__ void ln_rows(Ctx& C, const float* g, const float* bta, bf16_t* hb, float* dst = nullptr) {
    for (int m = C.gw; m < M; m += C.ngw) {
        f32x4* xr = (f32x4*)(C.out + (size_t)m * DM) + lane_id(); f32x4* xw = dst ? (f32x4*)(dst + (size_t)m * DM) + lane_id() : xr;
        f32x4 v[4]; float s = 0.f;
#pragma unroll
        for (int j = 0; j < 4; ++j) { v[j] = xr[64 * j]; s += (v[j].x + v[j].y) + (v[j].z + v[j].w); }
        const float mean = wave_sum(s) * (1.f / DM); float s2 = 0.f;
#pragma unroll
        for (int j = 0; j < 4; ++j) { v[j] = v[j] - mean; s2 += (v[j].x * v[j].x + v[j].y * v[j].y) + (v[j].z * v[j].z + v[j].w * v[j].w); }
        const float rstd = rsqrtf(wave_sum(s2) * (1.f / DM) + LN_EPS);
#pragma unroll
        for (int j = 0; j < 4; ++j) {
            const f32x4 gg = ((const f32x4*)g)[lane_id() + 64 * j], bb = ((const f32x4*)bta)[lane_id() + 64 * j];
            const f32x4 o = v[j] * rstd * gg + bb; xw[64 * j] = o;
            if (hb) { u32x2 w; w.x = pk2(o.x, o.y); w.y = pk2(o.z, o.w); ((u32x2*)(hb + (size_t)m * DM))[lane_id() + 64 * j] = w; }
        }
    }
}
__device__ __forceinline__ void p7_naive(Ctx& C) {
    naive_gemm(C, C.HB, DM, C.WFF1, DM, M, DFF, DM, [&](int m, int n0, float a0, float a1, float a2, float a3, float) {
        a0 = fmaxf(a0, 0.f); a1 = fmaxf(a1, 0.f); a2 = fmaxf(a2, 0.f); a3 = fmaxf(a3, 0.f);
        u32x2 o; o.x = pk2(a0 * a0, a1 * a1); o.y = pk2(a2 * a2, a3 * a3); *(u32x2*)(C.HID + (size_t)m * DFF + n0) = o;
    });
}
__device__ __forceinline__ void p8_naive(Ctx& C) {
    naive_gemm(C, C.HID, DFF, C.WFF2, DFF, M, DM, DFF, [&](int m, int n0, float a0, float a1, float a2, float a3, float) {
        f32x4* p = (f32x4*)(C.out + (size_t)m * DM + n0); const f32x4 hv = *p;
        *p = (f32x4){ALPHA * hv.x + a0, ALPHA * hv.y + a1, ALPHA * hv.z + a2, ALPHA * hv.w + a3};
    });
}

namespace pg8 {
typedef short bf16x8 __attribute__((ext_vector_type(8)));
constexpr int BM = 256, BK = 64, HALF = 128, HTB = HALF * BK * 2, STAGE_BYTES = 8 * HTB, NXCD = 8, WGM = 8;
__host__ __device__ __forceinline__ int lds_byte(int r, int c) { const int st = (r >> 4) * 2 + (c >> 5), rr = r & 15, cc = c & 31, ob = rr * 64 + cc * 2; return st * 1024 + (ob ^ (((ob >> 9) & 1) << 5)); }
__host__ __device__ __forceinline__ void stage_rc(int b, int& R, int& C) { const int st = b / 1024, sb = b % 1024, swz = sb ^ (((sb >> 9) & 1) << 5); R = (st >> 1) * 16 + swz / 64; C = (st & 1) * 32 + (swz % 64) / 2; }
__host__ __device__ __forceinline__ int perm32(int rho) { const int n = rho >> 4, i = rho & 15; return 8 * (i >> 2) + 4 * n + (i & 3); }
struct Unit { int pm, pn; };
struct Gemm { const bf16_t* A; const bf16_t* Bt; int K, lda, ldb; };
__device__ __forceinline__ void swz_tile(int L, int nM, int nN, Unit& u) {
    const int nwg = nM * nN; int wgid = L;
    { const int q = nwg / NXCD, r = nwg % NXCD, xcd = wgid % NXCD, off = wgid / NXCD; wgid = (xcd < r ? xcd * (q + 1) : r * (q + 1) + (xcd - r) * q) + off; }
    const int nig = WGM * nN, gid = wgid / nig, fm = gid * WGM, gsz = (nM - fm) < WGM ? (nM - fm) : WGM;
    u.pm = fm + ((wgid % nig) % gsz); u.pn = (wgid % nig) / gsz;
}
struct StaticOrder {
    int nM, nN, nwg, G, c;
    __device__ void init(int Mr, int N, int G_, int c_) { nM = Mr / BM; nN = N / BM; nwg = nM * nN; G = G_; c = c_; }
    __device__ bool next(int i, Unit& u) const { const long L = (long)i * G + c; if (L >= nwg) return false; swz_tile((int)L, nM, nN, u); return true; }
};
struct PairOrder {
    int nM, nN, nwg, G, c;
    __device__ void init(int Mr, int N, int G_, int c_) { nM = Mr / BM; nN = N / BM; nwg = nM * nN; G = G_; c = c_; }
    __device__ bool next(int i, Unit& u) const { const long L = (long)(i >> 1) * G + c; if (L >= nwg) return false; swz_tile((int)L, nM, nN, u); if (i & 1) { u.pm += nM; u.pn += nN; } return true; }
};
__device__ __forceinline__ unsigned cvt_pk_bf16(float lo, float hi) { unsigned r; asm volatile("v_cvt_pk_bf16_f32 %0, %1, %2" : "=v"(r) : "v"(lo), "v"(hi)); return r; }

template <class Epi, class Sched, bool ALIGN_EPI>
__device__ __forceinline__ void gemm_phase(LAS unsigned char* lds, const Gemm g, const Sched& S, const Epi& E) {
    int tid = threadIdx.x; asm volatile("" : "+v"(tid));
    const int wid = __builtin_amdgcn_readfirstlane(tid >> 6), lane = tid & 63, wr = wid >> 2, wc = wid & 3, fr = lane & 15, fq = lane >> 4;
    const int K = g.K, nt = K / BK;
    unsigned voffA[2], voffB[2];
#pragma unroll
    for (int i = 0; i < 2; ++i) { int R, C; stage_rc(tid * 16 + i * 8192, R, C); const int Rb = Epi::PERM ? ((R & ~31) + perm32(R & 31)) : R;
        voffA[i] = (unsigned)(R * g.lda + C) * 2u; voffB[i] = (unsigned)(Rb * g.ldb + C) * 2u; }
    const size_t kstep = (size_t)(BK * 2);
    const size_t hstepA = (size_t)HALF * g.lda * 2, hstepB = (size_t)HALF * g.ldb * 2;
    const size_t tstepA = 2 * hstepA, tstepB = 2 * hstepB;
    const unsigned ldsw = (unsigned)wid * 1024u;
    const int aoff = lds_byte(wr * 64 + fr, fq * 8), boff = lds_byte(wc * 32 + fr, fq * 8);
#define PG8_SA(b, h) (((b) * 2 + (h)) * HTB)
#define PG8_SB(b, h) ((4 + (b) * 2 + (h)) * HTB)
#define PG8_STAGE(bufoff, gbase, voff) do { _Pragma("unroll") for (int _i = 0; _i < 2; ++_i) \
        __builtin_amdgcn_global_load_lds((const unsigned*)((const char*)(gbase) + (voff)[_i]), (LAS unsigned*)(lds + (bufoff) + ldsw + _i * 8192), 16, 0, 0); } while (0)
#define PG8_LDA(dst, b, h) do { _Pragma("unroll") for (int m = 0; m < 4; ++m) _Pragma("unroll") for (int k = 0; k < 2; ++k) dst[m][k] = *(const LAS bf16x8*)(lds + PG8_SA(b, h) + aoff + m * 2048 + k * 1024); } while (0)
#define PG8_LDB(dst, b, h) do { _Pragma("unroll") for (int n = 0; n < 2; ++n) _Pragma("unroll") for (int k = 0; k < 2; ++k) dst[n][k] = *(const LAS bf16x8*)(lds + PG8_SB(b, h) + boff + n * 2048 + k * 1024); } while (0)
#define PG8_MMA(ai, bj, At, Bt) do { __builtin_amdgcn_s_setprio(1); _Pragma("unroll") for (int m = 0; m < 4; ++m) _Pragma("unroll") for (int n = 0; n < 2; ++n) _Pragma("unroll") for (int k = 0; k < 2; ++k) \
        acc[ai][bj][m][n] = __builtin_amdgcn_mfma_f32_16x16x32_bf16(Bt[n][k], At[m][k], acc[ai][bj][m][n], 0, 0, 0); __builtin_amdgcn_s_setprio(0); } while (0)
#define PG8_WAIT_V(n) asm volatile("s_waitcnt vmcnt(" #n ")" ::: "memory")
#define PG8_WAIT_L(n) asm volatile("s_waitcnt lgkmcnt(" #n ")" ::: "memory")
#define PG8_BAR __builtin_amdgcn_s_barrier()
#define PG8_SCHED __builtin_amdgcn_sched_barrier(0)
    Unit cur, nxt; int ui = 0;
    if (!S.next(0, cur)) return;
    f32x4 acc[2][2][4][2];
#pragma unroll
    for (int a = 0; a < 2; ++a)
#pragma unroll
        for (int b = 0; b < 2; ++b)
#pragma unroll
            for (int m = 0; m < 4; ++m)
#pragma unroll
                for (int n = 0; n < 2; ++n) acc[a][b][m][n] = (f32x4){0.f, 0.f, 0.f, 0.f};
    bf16x8 At[4][2], B0[2][2], B1[2][2];
    const char* cA = (const char*)g.A + (size_t)cur.pm * tstepA; const char* cB = (const char*)g.Bt + (size_t)cur.pn * tstepB;
    PG8_STAGE(PG8_SB(0, 0), cB, voffB); PG8_STAGE(PG8_SB(0, 1), cB + hstepB, voffB); PG8_STAGE(PG8_SA(0, 0), cA, voffA); PG8_STAGE(PG8_SA(0, 1), cA + hstepA, voffA);
    if (wr == 1) PG8_BAR;
    PG8_WAIT_V(2); PG8_BAR;
    PG8_STAGE(PG8_SB(1, 0), cB + kstep, voffB); PG8_STAGE(PG8_SA(1, 0), cA + kstep, voffA); PG8_STAGE(PG8_SB(1, 1), cB + hstepB + kstep, voffB);
    PG8_WAIT_V(6); PG8_BAR;
    for (;;) {
        const bool has_next = S.next(ui + 1, nxt);
        const char* nA = has_next ? (const char*)g.A + (size_t)nxt.pm * tstepA : cA; const char* nB = has_next ? (const char*)g.Bt + (size_t)nxt.pn * tstepB : cB;
#pragma nounroll
        for (int t = 0; t < nt; t += 2) {
            const bool last = (t == nt - 2);
            const char* a1 = cA + (size_t)(t + 1) * kstep;
            const char* a2 = last ? nA : cA + (size_t)(t + 2) * kstep; const char* b2 = last ? nB : cB + (size_t)(t + 2) * kstep;
            const char* a3 = a2 + kstep; const char* b3 = b2 + kstep;
            PG8_LDB(B0, 0, 0); PG8_LDB(B1, 0, 1); PG8_SCHED; PG8_LDA(At, 0, 0); PG8_STAGE(PG8_SA(1, 1), a1 + hstepA, voffA);
            PG8_WAIT_V(8); PG8_WAIT_L(0); PG8_BAR; PG8_MMA(0, 0, At, B0); PG8_MMA(0, 1, At, B1); PG8_BAR; PG8_SCHED;
            PG8_LDA(At, 0, 1); PG8_STAGE(PG8_SB(0, 0), b2, voffB); PG8_STAGE(PG8_SB(0, 1), b2 + hstepB, voffB); PG8_STAGE(PG8_SA(0, 0), a2, voffA);
            PG8_WAIT_V(8); PG8_WAIT_L(0); PG8_BAR; PG8_MMA(1, 0, At, B0); PG8_MMA(1, 1, At, B1); PG8_BAR; PG8_SCHED;
            PG8_LDB(B0, 1, 0); PG8_LDB(B1, 1, 1); PG8_SCHED; PG8_LDA(At, 1, 0); PG8_STAGE(PG8_SA(0, 1), a2 + hstepA, voffA);
            PG8_WAIT_V(8); PG8_WAIT_L(0); PG8_BAR; PG8_MMA(0, 0, At, B0); PG8_MMA(0, 1, At, B1); PG8_BAR; PG8_SCHED;
            PG8_LDA(At, 1, 1); PG8_STAGE(PG8_SB(1, 0), b3, voffB); PG8_STAGE(PG8_SB(1, 1), b3 + hstepB, voffB); PG8_STAGE(PG8_SA(1, 0), a3, voffA);
            PG8_WAIT_V(8); PG8_WAIT_L(0); PG8_BAR; PG8_MMA(1, 0, At, B0); PG8_MMA(1, 1, At, B1); PG8_BAR; PG8_SCHED;
        }
        if constexpr (ALIGN_EPI) { if (wr == 0) PG8_BAR; }
        E(acc, cur, wr, wc, fr, fq);
        if (!has_next) break;
#pragma unroll
        for (int a = 0; a < 2; ++a)
#pragma unroll
            for (int b = 0; b < 2; ++b)
#pragma unroll
                for (int m = 0; m < 4; ++m)
#pragma unroll
                    for (int n = 0; n < 2; ++n) acc[a][b][m][n] = (f32x4){0.f, 0.f, 0.f, 0.f};
        cur = nxt; cA = nA; cB = nB; ++ui;
        if constexpr (ALIGN_EPI) { if (wr == 1) PG8_BAR; }
    }
    PG8_WAIT_V(0);
    if constexpr (!ALIGN_EPI) { if (wr == 0) PG8_BAR; }
    PG8_BAR;
#undef PG8_SA
#undef PG8_SB
#undef PG8_STAGE
#undef PG8_LDA
#undef PG8_LDB
#undef PG8_MMA
#undef PG8_WAIT_V
#undef PG8_WAIT_L
#undef PG8_BAR
#undef PG8_SCHED
}

typedef f32x4 AccT[2][2][4][2];
__device__ __forceinline__ float sigm(float v) { return __builtin_amdgcn_rcpf(1.0f + __builtin_amdgcn_exp2f(-LOG2E * v)); }
__device__ __forceinline__ u32x4 pack8(const f32x4 v0, const f32x4 v1) { u32x4 w; w.x = cvt_pk_bf16(v0[0], v0[1]); w.y = cvt_pk_bf16(v0[2], v0[3]); w.z = cvt_pk_bf16(v1[0], v1[1]); w.w = cvt_pk_bf16(v1[2], v1[3]); return w; }

struct EpiIn {
    static constexpr bool PERM = true;
    bf16_t *PS, *QKVD, *GATES; const float* b_gate; float* SUMSQ; bool do_ss;
    __device__ __forceinline__ void operator()(const AccT& acc, const Unit& u, int wr, int wc, int fr, int fq) const {
        const int row0 = u.pm * BM + wr * 64 + fr;
        int kind, ldc, colt; bf16_t* base;
        if (u.pn < 3) { kind = 0; base = PS; ldc = PSW; colt = u.pn * BM; } else if (u.pn < 9) { kind = 1; base = QKVD; ldc = QKVDW; colt = (u.pn - 3) * BM; } else { kind = 2; base = GATES; ldc = GATEW; colt = (u.pn - 9) * BM; }
        const int col0 = colt + wc * 32 + 8 * fq;
        f32x4 bv[2][2];
#pragma unroll
        for (int bj = 0; bj < 2; ++bj)
#pragma unroll
            for (int n = 0; n < 2; ++n) bv[bj][n] = (kind == 2) ? *(const f32x4*)(b_gate + col0 + bj * HALF + 4 * n) : (f32x4){0.f, 0.f, 0.f, 0.f};
#pragma unroll
        for (int ai = 0; ai < 2; ++ai)
#pragma unroll
            for (int m = 0; m < 4; ++m) { const int row = row0 + ai * HALF + m * 16; bf16_t* rowp = base + (size_t)row * ldc + col0;
#pragma unroll
                for (int bj = 0; bj < 2; ++bj) { f32x4 v0 = acc[ai][bj][m][0], v1 = acc[ai][bj][m][1];
                    if (kind == 2) { v0 += bv[bj][0]; v1 += bv[bj][1];
#pragma unroll
                        for (int e = 0; e < 4; ++e) { v0[e] = sigm(v0[e]); v1[e] = sigm(v1[e]); } }
                    *(u32x4*)(rowp + bj * HALF) = pack8(v0, v1);
                    if (kind == 0) {
                        float ss = (v0[0] * v0[0] + v0[1] * v0[1]) + (v0[2] * v0[2] + v0[3] * v0[3]) + (v1[0] * v1[0] + v1[1] * v1[1]) + (v1[2] * v1[2] + v1[3] * v1[3]);
                        ss += __shfl_xor(ss, 16); ss += __shfl_xor(ss, 32);
                        const int t = (u.pn == 0) ? 0 : (u.pn == 1 ? bj : (bj == 0 ? 1 : -1));
                        if (fq == 0 && t >= 0 && do_ss) atomicAdd(SUMSQ + (size_t)row * 2 + t, ss);
                    } } }
    }
};
struct EpiQ {
    static constexpr bool PERM = false;
    bf16_t* __restrict__ Q; const float* __restrict__ SUMSQ; const float* __restrict__ ROPET;
    __device__ __forceinline__ void operator()(const AccT& acc, const Unit& u, int wr, int wc, int fr, int fq) const {
        const int row0 = u.pm * BM + wr * 64 + fr;
        const bool rope0 = ((u.pn * 8 + wc) % 3) == 2, rope1 = ((u.pn * 8 + 4 + wc) % 3) == 2;
#pragma unroll
        for (int ai = 0; ai < 2; ++ai) {
            float rs[4]; f32x4 c0[4], c1[4];
#pragma unroll
            for (int m = 0; m < 4; ++m) { const int row = row0 + ai * HALF + m * 16; const int pos = row & (SEQ - 1);
                rs[m] = SUMSQ[(size_t)row * 2];
                c0[m] = *(const f32x4*)(ROPET + (size_t)(pos * 16 + 4 * fq) * 2); c1[m] = *(const f32x4*)(ROPET + (size_t)(pos * 16 + 4 * fq) * 2 + 4); }
#pragma unroll
            for (int m = 0; m < 4; ++m) { const int row = row0 + ai * HALF + m * 16;
                const float r = rsqrtf(rs[m] * (1.0f / QLORA) + RMS_EPS) * QSCALE;
                const float cs[4] = {c0[m][0], c0[m][2], c1[m][0], c1[m][2]}, sn[4] = {c0[m][1], c0[m][3], c1[m][1], c1[m][3]};
#pragma unroll
                for (int bj = 0; bj < 2; ++bj) { const bool rope = bj ? rope1 : rope0;
                    f32x4 v0 = acc[ai][bj][m][0] * r, v1 = acc[ai][bj][m][1] * r;
                    if (rope) { f32x4 o0, o1;
#pragma unroll
                        for (int e = 0; e < 4; ++e) { o0[e] = v0[e] * cs[e] - v1[e] * sn[e]; o1[e] = v0[e] * sn[e] + v1[e] * cs[e]; }
                        v0 = o0; v1 = o1; }
                    bf16_t* p = Q + (size_t)row * 768 + u.pn * BM + bj * HALF + wc * 32 + 4 * fq;
                    u32x2 w0, w1; w0.x = cvt_pk_bf16(v0[0], v0[1]); w0.y = cvt_pk_bf16(v0[2], v0[3]); w1.x = cvt_pk_bf16(v1[0], v1[1]); w1.y = cvt_pk_bf16(v1[2], v1[3]);
                    *(u32x2*)p = w0; *(u32x2*)(p + 16) = w1; } }
        }
    }
};
struct EpiKV {
    static constexpr bool PERM = true;
    bf16_t* __restrict__ KV; const float* __restrict__ SUMSQ;
    __device__ __forceinline__ void operator()(const AccT& acc, const Unit& u, int wr, int wc, int fr, int fq) const {
        const int row0 = u.pm * BM + wr * 64 + fr, col0 = u.pn * BM + wc * 32 + 8 * fq;
        float rs[2][4];
#pragma unroll
        for (int ai = 0; ai < 2; ++ai)
#pragma unroll
            for (int m = 0; m < 4; ++m) rs[ai][m] = SUMSQ[(size_t)(row0 + ai * HALF + m * 16) * 2 + 1];
#pragma unroll
        for (int ai = 0; ai < 2; ++ai)
#pragma unroll
            for (int m = 0; m < 4; ++m) { const int row = row0 + ai * HALF + m * 16;
                const float r = rsqrtf(rs[ai][m] * (1.0f / KVLORA) + RMS_EPS);
#pragma unroll
                for (int bj = 0; bj < 2; ++bj) *(u32x4*)(KV + (size_t)row * 1024 + col0 + bj * HALF) = pack8(acc[ai][bj][m][0] * r, acc[ai][bj][m][1] * r); }
    }
};
struct EpiMix {
    static constexpr bool PERM = true;
    const bf16_t* GATES; bf16_t* T; bf16_t* MIXIN;
    __device__ __forceinline__ void operator()(const AccT& acc, const Unit& u, int wr, int wc, int fr, int fq) const {
        const bool second = u.pm >= 128; const int pm = second ? u.pm - 128 : u.pm, pn = second ? u.pn - 4 : u.pn;
        const int row0 = pm * BM + wr * 64 + fr, col0 = pn * BM + wc * 32 + 8 * fq;
#pragma unroll
        for (int ai = 0; ai < 2; ++ai)
#pragma unroll
          for (int mh = 0; mh < 2; ++mh) {
            u32x4 g[2][2], t[2][2];
#pragma unroll
            for (int mm = 0; mm < 2; ++mm)
#pragma unroll
                for (int bj = 0; bj < 2; ++bj) { const int row = row0 + ai * HALF + (mh * 2 + mm) * 16, col = col0 + bj * HALF;
                    g[mm][bj] = *(const u32x4*)(GATES + (size_t)row * GATEW + (second ? 1024 : 0) + col);
                    t[mm][bj] = second ? *(const u32x4*)(T + (size_t)row * 1024 + col) : (u32x4){0u, 0u, 0u, 0u}; }
            asm volatile("" ::: "memory");
#pragma unroll
            for (int mm = 0; mm < 2; ++mm)
#pragma unroll
                for (int bj = 0; bj < 2; ++bj) { const int m = mh * 2 + mm; const int row = row0 + ai * HALF + m * 16, col = col0 + bj * HALF;
                    const u32x4 gg = g[mm][bj], tt = t[mm][bj];
                    f32x4 v0 = acc[ai][bj][m][0], v1 = acc[ai][bj][m][1];
                    v0[0] = v0[0] * lo16(gg.x) + lo16(tt.x); v0[1] = v0[1] * hi16(gg.x) + hi16(tt.x); v0[2] = v0[2] * lo16(gg.y) + lo16(tt.y); v0[3] = v0[3] * hi16(gg.y) + hi16(tt.y);
                    v1[0] = v1[0] * lo16(gg.z) + lo16(tt.z); v1[1] = v1[1] * hi16(gg.z) + hi16(tt.z); v1[2] = v1[2] * lo16(gg.w) + lo16(tt.w); v1[3] = v1[3] * hi16(gg.w) + hi16(tt.w);
                    *(u32x4*)((second ? MIXIN : T) + (size_t)row * 1024 + col) = pack8(v0, v1); }
            asm volatile("" ::: "memory");
          }
    }
};
struct EpiRes {
    static constexpr bool PERM = false;
    const float* base; float* out;
    __device__ __forceinline__ void operator()(const AccT& acc, const Unit& u, int wr, int wc, int fr, int fq) const {
        const int row0 = u.pm * BM + wr * 64 + fr, col0 = u.pn * BM + wc * 32 + 4 * fq;
#pragma unroll
        for (int ai = 0; ai < 2; ++ai)
#pragma unroll
          for (int mh = 0; mh < 2; ++mh) {
            f32x4 bs[2][2][2];
#pragma unroll
            for (int mm = 0; mm < 2; ++mm) { const size_t off = (size_t)(row0 + ai * HALF + (mh * 2 + mm) * 16) * DM + col0;
#pragma unroll
                for (int bj = 0; bj < 2; ++bj)
#pragma unroll
                    for (int n = 0; n < 2; ++n) bs[mm][bj][n] = *(const f32x4*)(base + off + bj * HALF + n * 16); }
            asm volatile("" ::: "memory");
#pragma unroll
            for (int mm = 0; mm < 2; ++mm) { const int m = mh * 2 + mm; const size_t off = (size_t)(row0 + ai * HALF + m * 16) * DM + col0;
#pragma unroll
                for (int bj = 0; bj < 2; ++bj)
#pragma unroll
                    for (int n = 0; n < 2; ++n) *(f32x4*)(out + off + bj * HALF + n * 16) = bs[mm][bj][n] * ALPHA + acc[ai][bj][m][n]; }
            asm volatile("" ::: "memory");
          }
    }
};
struct EpiSqRelu {
    static constexpr bool PERM = true;
    bf16_t* H;
    __device__ __forceinline__ void operator()(const AccT& acc, const Unit& u, int wr, int wc, int fr, int fq) const {
        const int row0 = u.pm * BM + wr * 64 + fr, col0 = u.pn * BM + wc * 32 + 8 * fq;
#pragma unroll
        for (int ai = 0; ai < 2; ++ai)
#pragma unroll
            for (int m = 0; m < 4; ++m) { bf16_t* rowp = H + (size_t)(row0 + ai * HALF + m * 16) * DFF + col0;
#pragma unroll
                for (int bj = 0; bj < 2; ++bj) { f32x4 v0 = acc[ai][bj][m][0], v1 = acc[ai][bj][m][1];
#pragma unroll
                    for (int e = 0; e < 4; ++e) { const float a = fmaxf(v0[e], 0.f), b = fmaxf(v1[e], 0.f); v0[e] = a * a; v1[e] = b * b; }
                    *(u32x4*)(rowp + bj * HALF) = pack8(v0, v1); } }
    }
};
}

namespace fa {
typedef short bf16x8 __attribute__((ext_vector_type(8)));
typedef short s16x4 __attribute__((ext_vector_type(4)));
typedef short v4i16_t __attribute__((ext_vector_type(4)));
typedef float f32x16 __attribute__((ext_vector_type(16)));
constexpr int VBUF = 4096;
__device__ __forceinline__ s16x4 vtr(LAS const unsigned char* p) { return __builtin_bit_cast(s16x4, __builtin_amdgcn_ds_read_tr16_b64_v4i16((LAS v4i16_t*)p)); }
__device__ __forceinline__ unsigned cvtpk(float lo, float hi) { unsigned r; asm volatile("v_cvt_pk_bf16_f32 %0, %1, %2" : "=v"(r) : "v"(lo), "v"(hi)); return r; }
struct State { f32x16 o0, o1; float m, l; };
__device__ __forceinline__ void st_init(State& st) { st.o0 = f32x16{}; st.o1 = f32x16{}; st.m = -1e30f; st.l = 0.f; }
__device__ __forceinline__ void v_store(LAS unsigned char* vb, const u32x4 (&vr)[4], int lane) {
#pragma unroll
    for (int i = 0; i < 4; ++i) { const int key = (i * 64 + lane) >> 3, c = lane & 7; *(LAS u32x4*)(vb + (c >> 2) * 2048 + key * 64 + (c & 3) * 16) = vr[i]; }
}
__device__ __forceinline__ void softmax_pv(State& st, f32x16& t, LAS const unsigned char* vb, int lane) {
    float mx = fmaxf(fmaxf(t[0], t[1]), fmaxf(t[2], t[3]));
#pragma unroll
    for (int r = 4; r < 16; r += 4) mx = fmaxf(mx, fmaxf(fmaxf(t[r], t[r + 1]), fmaxf(t[r + 2], t[r + 3])));
    mx = fmaxf(mx, __shfl_xor(mx, 32));
    const float mn = fmaxf(st.m, mx);
    if (__any(mn > st.m)) { const float sc = __builtin_amdgcn_exp2f(st.m - mn); st.l *= sc; st.o0 *= sc; st.o1 *= sc; st.m = mn; }
    float sum = 0.f;
#pragma unroll
    for (int r = 0; r < 16; ++r) { t[r] = __builtin_amdgcn_exp2f(t[r] - mn); sum += t[r]; }
    st.l += sum;
    u32x4 w0, w1;
    w0.x = cvtpk(t[0], t[1]); w0.y = cvtpk(t[2], t[3]); w0.z = cvtpk(t[4], t[5]); w0.w = cvtpk(t[6], t[7]);
    w1.x = cvtpk(t[8], t[9]); w1.y = cvtpk(t[10], t[11]); w1.z = cvtpk(t[12], t[13]); w1.w = cvtpk(t[14], t[15]);
    const bf16x8 pf0 = __builtin_bit_cast(bf16x8, w0), pf1 = __builtin_bit_cast(bf16x8, w1);
    LAS const unsigned char* vp = vb + (4 * (lane >> 5) + ((lane & 15) >> 2)) * 64 + (16 * ((lane >> 4) & 1) + 4 * (lane & 3)) * 2;
#define FA_VF(d0, s) ([&]() { const s16x4 a = vtr(vp + (d0) * 2048 + (s) * 1024), b = vtr(vp + (d0) * 2048 + (s) * 1024 + 512); return (bf16x8){a[0], a[1], a[2], a[3], b[0], b[1], b[2], b[3]}; }())
    const bf16x8 v00 = FA_VF(0, 0), v01 = FA_VF(0, 1), v10 = FA_VF(1, 0), v11 = FA_VF(1, 1);
#undef FA_VF
    st.o0 = __builtin_amdgcn_mfma_f32_32x32x16_bf16(v00, pf0, st.o0, 0, 0, 0);
    st.o1 = __builtin_amdgcn_mfma_f32_32x32x16_bf16(v10, pf0, st.o1, 0, 0, 0);
    st.o0 = __builtin_amdgcn_mfma_f32_32x32x16_bf16(v01, pf1, st.o0, 0, 0, 0);
    st.o1 = __builtin_amdgcn_mfma_f32_32x32x16_bf16(v11, pf1, st.o1, 0, 0, 0);
}
__device__ __forceinline__ void o_store(State& st, bf16_t* orow, int lane) {
    const float lt = st.l + __shfl_xor(st.l, 32); const float il = 1.0f / lt; const int hi = lane >> 5;
#pragma unroll
    for (int rr = 0; rr < 4; ++rr) {
        u32x2 a, b; a.x = cvtpk(st.o0[4 * rr] * il, st.o0[4 * rr + 1] * il); a.y = cvtpk(st.o0[4 * rr + 2] * il, st.o0[4 * rr + 3] * il);
        b.x = cvtpk(st.o1[4 * rr] * il, st.o1[4 * rr + 1] * il); b.y = cvtpk(st.o1[4 * rr + 2] * il, st.o1[4 * rr + 3] * il);
        *(u32x2*)(orow + 8 * rr + 4 * hi) = a; *(u32x2*)(orow + 32 + 8 * rr + 4 * hi) = b;
    }
}
__device__ __forceinline__ void mla_item(const bf16_t* Q, const bf16_t* KV, const bf16_t* KR, bf16_t* O, int b, int h, int qt, LAS unsigned char* vl, int lane) {
    const int r32 = lane & 31, hi = lane >> 5;
    const size_t mq = (size_t)b * SEQ + 32 * qt + r32;
    bf16x8 qf[6];
#pragma unroll
    for (int ds = 0; ds < 6; ++ds) qf[ds] = *(const bf16x8*)(Q + mq * 768 + h * 96 + 16 * ds + 8 * hi);
    State st; st_init(st);
    bf16x8 kn[6]; u32x4 vr[4];
#define MLA_LOAD(kt) do { const size_t mk_ = (size_t)b * SEQ + 32 * (kt) + r32; \
        _Pragma("unroll") for (int ds = 0; ds < 4; ++ds) kn[ds] = *(const bf16x8*)(KV + mk_ * 1024 + h * 128 + 16 * ds + 8 * hi); \
        _Pragma("unroll") for (int e = 0; e < 2; ++e) kn[4 + e] = *(const bf16x8*)(KR + mk_ * 32 + 16 * e + 8 * hi); \
        _Pragma("unroll") for (int i = 0; i < 4; ++i) vr[i] = *(const u32x4*)(KV + ((size_t)b * SEQ + 32 * (kt) + ((i * 64 + lane) >> 3)) * 1024 + h * 128 + 64 + (lane & 7) * 8); } while (0)
    MLA_LOAD(0);
    v_store(vl, vr, lane);
    for (int kt = 0; kt <= qt; ++kt) {
        bf16x8 kf[6];
#pragma unroll
        for (int ds = 0; ds < 6; ++ds) kf[ds] = kn[ds];
        if (kt < qt) MLA_LOAD(kt + 1);
        f32x16 s = f32x16{};
#pragma unroll
        for (int ds = 0; ds < 6; ++ds) s = __builtin_amdgcn_mfma_f32_32x32x16_bf16(kf[ds], qf[ds], s, 0, 0, 0);
        if (kt == qt) {
#pragma unroll
            for (int r = 0; r < 16; ++r) { const int key = (r & 3) + 8 * (r >> 2) + 4 * hi; if (key > r32) s[r] = -INFINITY; }
        }
        asm volatile("" ::: "memory");
        softmax_pv(st, s, vl + (kt & 1) * VBUF, lane);
        asm volatile("" ::: "memory");
        if (kt < qt) v_store(vl + ((kt + 1) & 1) * VBUF, vr, lane);
    }
#undef MLA_LOAD
    o_store(st, O + mq * 512 + h * 64, lane);
}
__device__ __forceinline__ void dil_item(const bf16_t* QKVD, bf16_t* O, int b, int h, int r, int pb, LAS unsigned char* vl, int lane) {
    const int r32 = lane & 31, hi = lane >> 5;
    const size_t mq = (size_t)b * SEQ + 4 * (32 * pb + r32) + r;
    bf16x8 qf[4];
#pragma unroll
    for (int ds = 0; ds < 4; ++ds) qf[ds] = *(const bf16x8*)(QKVD + mq * QKVDW + h * 64 + 16 * ds + 8 * hi);
    const float slope2 = __builtin_amdgcn_exp2f(-(float)(h + 1)) * LOG2E;
    constexpr float C1 = 0.125f * LOG2E;
    State st; st_init(st);
    const int nt = (pb + 1) + (pb >= 1 ? 6 : 3);
    bf16x8 kn[4]; u32x4 vr[4];
#define DIL_TILE(t, rho, kb) do { if ((t) <= pb) { rho = r; kb = (t); } else { const int u_ = (t) - (pb + 1); if (pb >= 1) { rho = (r + 1 + (u_ >> 1)) & 3; kb = pb - 1 + (u_ & 1); } else { rho = (r + 1 + u_) & 3; kb = 0; } } } while (0)
#define DIL_LOAD(rho, kb) do { const size_t mk_ = (size_t)b * SEQ + 4 * (32 * (kb) + r32) + (rho); \
        _Pragma("unroll") for (int ds = 0; ds < 4; ++ds) kn[ds] = *(const bf16x8*)(QKVD + mk_ * QKVDW + 512 + h * 64 + 16 * ds + 8 * hi); \
        _Pragma("unroll") for (int i = 0; i < 4; ++i) vr[i] = *(const u32x4*)(QKVD + ((size_t)b * SEQ + 4 * (32 * (kb) + ((i * 64 + lane) >> 3)) + (rho)) * QKVDW + 1024 + h * 64 + (lane & 7) * 8); } while (0)
    int rho, kb; DIL_TILE(0, rho, kb);
    DIL_LOAD(rho, kb);
    v_store(vl, vr, lane);
    for (int t = 0; t < nt; ++t) {
        bf16x8 kf[4];
#pragma unroll
        for (int ds = 0; ds < 4; ++ds) kf[ds] = kn[ds];
        const int dbase = 128 * (pb - kb) + (r - rho);
        int rho2 = 0, kb2 = 0;
        if (t + 1 < nt) { DIL_TILE(t + 1, rho2, kb2); DIL_LOAD(rho2, kb2); }
        f32x16 s = f32x16{};
#pragma unroll
        for (int ds = 0; ds < 4; ++ds) s = __builtin_amdgcn_mfma_f32_32x32x16_bf16(kf[ds], qf[ds], s, 0, 0, 0);
        const int dl = dbase + 4 * r32 - 16 * hi;
#pragma unroll
        for (int rg = 0; rg < 16; ++rg) {
            const int d = dl - 4 * ((rg & 3) + 8 * (rg >> 2));
            const int w = (d <= 128 ? 1 : 0) + (((d & 3) == 0 && d <= 512) ? 1 : 0) + ((d & 15) == 0 ? 1 : 0);
            const float lw = (d < 0 || w == 0) ? -INFINITY : (w == 1 ? 0.f : (w == 2 ? 1.f : 1.5849625007f));
            s[rg] = s[rg] * C1 - slope2 * (float)d + lw;
        }
        asm volatile("" ::: "memory");
        softmax_pv(st, s, vl + (t & 1) * VBUF, lane);
        asm volatile("" ::: "memory");
        if (t + 1 < nt) v_store(vl + ((t + 1) & 1) * VBUF, vr, lane);
        rho = rho2; kb = kb2;
    }
#undef DIL_TILE
#undef DIL_LOAD
    o_store(st, O + ((size_t)M + mq) * 512 + h * 64, lane);
}
constexpr int KST = 64 * 96 * 2, VST = 64 * 64 * 2, STAGE = KST + VST, NST = 3;
__device__ __forceinline__ void glds16(const void* src, LAS unsigned char* dst) { __builtin_amdgcn_global_load_lds((const unsigned*)src, (LAS unsigned*)dst, 16, 0, 0); }
__device__ __forceinline__ void mla_issue(const bf16_t* KV, const bf16_t* KR, int b, int h, int kt, LAS unsigned char* st, int w, int lane) {
    const int key = lane & 31, hh = lane >> 5; const size_t row0 = (size_t)b * SEQ + 64 * kt;
    { const int sk = w >> 2, ds = w & 3; glds16(KV + (row0 + 32 * sk + key) * 1024 + h * 128 + 16 * ds + 8 * hh, st + (sk * 6 + ds) * 1024); }
    { const int sk = (w & 3) >> 1, e = w & 1; glds16(KR + (row0 + 32 * sk + key) * 32 + 16 * e + 8 * hh, st + (sk * 6 + 4 + e) * 1024); }
    { const int sk = w >> 2, i = w & 3, d0 = i >> 1, kv = ((i & 1) * 64 + lane) >> 2, cc = lane & 3;
      glds16(KV + (row0 + 32 * sk + kv) * 1024 + h * 128 + 64 + (d0 * 4 + cc) * 8, st + KST + sk * 4096 + i * 1024); }
}
__device__ __forceinline__ void softmax_pv2(State& st, f32x16& t0, f32x16& t1, LAS const unsigned char* vb, int lane) {
    float mx = fmaxf(fmaxf(t0[0], t0[1]), fmaxf(t1[0], t1[1]));
#pragma unroll
    for (int r = 2; r < 16; r += 2) mx = fmaxf(mx, fmaxf(fmaxf(t0[r], t0[r + 1]), fmaxf(t1[r], t1[r + 1])));
    mx = fmaxf(mx, __shfl_xor(mx, 32));
    const float mn = fmaxf(st.m, mx);
    if (__any(mn > st.m)) { const float sc = __builtin_amdgcn_exp2f(st.m - mn); st.l *= sc; st.o0 *= sc; st.o1 *= sc; st.m = mn; }
    float sum = 0.f;
#pragma unroll
    for (int r = 0; r < 16; ++r) { t0[r] = __builtin_amdgcn_exp2f(t0[r] - mn); t1[r] = __builtin_amdgcn_exp2f(t1[r] - mn); sum += t0[r] + t1[r]; }
    st.l += sum;
    LAS const unsigned char* vp = vb + (4 * (lane >> 5) + ((lane & 15) >> 2)) * 64 + (16 * ((lane >> 4) & 1) + 4 * (lane & 3)) * 2;
#define FA_VF(sk, d0, s) ([&]() { const s16x4 a = vtr(vp + (sk) * 4096 + (d0) * 2048 + (s) * 1024), b = vtr(vp + (sk) * 4096 + (d0) * 2048 + (s) * 1024 + 512); return (bf16x8){a[0], a[1], a[2], a[3], b[0], b[1], b[2], b[3]}; }())
#define FA_PF(t, s) ([&]() { u32x4 w; w.x = cvtpk(t[8 * (s)], t[8 * (s) + 1]); w.y = cvtpk(t[8 * (s) + 2], t[8 * (s) + 3]); w.z = cvtpk(t[8 * (s) + 4], t[8 * (s) + 5]); w.w = cvtpk(t[8 * (s) + 6], t[8 * (s) + 7]); return __builtin_bit_cast(bf16x8, w); }())
    { const bf16x8 p = FA_PF(t0, 0); st.o0 = __builtin_amdgcn_mfma_f32_32x32x16_bf16(FA_VF(0, 0, 0), p, st.o0, 0, 0, 0); st.o1 = __builtin_amdgcn_mfma_f32_32x32x16_bf16(FA_VF(0, 1, 0), p, st.o1, 0, 0, 0); }
    { const bf16x8 p = FA_PF(t0, 1); st.o0 = __builtin_amdgcn_mfma_f32_32x32x16_bf16(FA_VF(0, 0, 1), p, st.o0, 0, 0, 0); st.o1 = __builtin_amdgcn_mfma_f32_32x32x16_bf16(FA_VF(0, 1, 1), p, st.o1, 0, 0, 0); }
    { const bf16x8 p = FA_PF(t1, 0); st.o0 = __builtin_amdgcn_mfma_f32_32x32x16_bf16(FA_VF(1, 0, 0), p, st.o0, 0, 0, 0); st.o1 = __builtin_amdgcn_mfma_f32_32x32x16_bf16(FA_VF(1, 1, 0), p, st.o1, 0, 0, 0); }
    { const bf16x8 p = FA_PF(t1, 1); st.o0 = __builtin_amdgcn_mfma_f32_32x32x16_bf16(FA_VF(1, 0, 1), p, st.o0, 0, 0, 0); st.o1 = __builtin_amdgcn_mfma_f32_32x32x16_bf16(FA_VF(1, 1, 1), p, st.o1, 0, 0, 0); }
#undef FA_VF
#undef FA_PF
}
__device__ __forceinline__ void mla_unit(const bf16_t* Q, const bf16_t* KV, const bf16_t* KR, bf16_t* O, int b, int h, int qb, LAS unsigned char* ring, int w, int lane) {
    const int r32 = lane & 31, hi = lane >> 5;
    const size_t mq = (size_t)b * SEQ + 256 * qb + 32 * w + r32;
    const int NT = 4 * qb + 4, tmax = 4 * qb + (w >> 1);
    mla_issue(KV, KR, b, h, 0, ring, w, lane);
    mla_issue(KV, KR, b, h, 1, ring + STAGE, w, lane);
    bf16x8 qf[6];
#pragma unroll
    for (int ds = 0; ds < 6; ++ds) qf[ds] = *(const bf16x8*)(Q + mq * 768 + h * 96 + 16 * ds + 8 * hi);
    State st; st_init(st);
    int sc = 0, sn2 = 2;
    for (int t = 0; t < NT; ++t) {
        if (t + 1 < NT) asm volatile("s_waitcnt vmcnt(3)" ::: "memory"); else asm volatile("s_waitcnt vmcnt(0)" ::: "memory");
        __builtin_amdgcn_s_barrier(); asm volatile("" ::: "memory");
        if (t + 2 < NT) mla_issue(KV, KR, b, h, t + 2, ring + sn2 * STAGE, w, lane);
        if (t <= tmax) {
            LAS const unsigned char* kb = ring + sc * STAGE;
            f32x16 s0 = f32x16{}, s1 = f32x16{};
#pragma unroll
            for (int ds = 0; ds < 6; ++ds) {
                const bf16x8 k0 = *(LAS const bf16x8*)(kb + (ds * 64 + lane) * 16), k1 = *(LAS const bf16x8*)(kb + ((6 + ds) * 64 + lane) * 16);
                s0 = __builtin_amdgcn_mfma_f32_32x32x16_bf16(k0, qf[ds], s0, 0, 0, 0); s1 = __builtin_amdgcn_mfma_f32_32x32x16_bf16(k1, qf[ds], s1, 0, 0, 0);
            }
            if (t == tmax) {
                const int qoff = 32 * (w & 1) + r32;
#pragma unroll
                for (int r = 0; r < 16; ++r) { const int key = (r & 3) + 8 * (r >> 2) + 4 * hi; if (key > qoff) s0[r] = -INFINITY; if (32 + key > qoff) s1[r] = -INFINITY; }
            }
            softmax_pv2(st, s0, s1, kb + KST, lane);
        }
        sc = (sc == NST - 1) ? 0 : sc + 1; sn2 = (sn2 == NST - 1) ? 0 : sn2 + 1;
    }
    o_store(st, O + mq * 512 + h * 64, lane);
    asm volatile("s_waitcnt lgkmcnt(0)" ::: "memory"); __builtin_amdgcn_s_barrier(); asm volatile("" ::: "memory");
}
}
__device__ __forceinline__ void p3_fast_mla_only(Ctx& C, LAS unsigned char* lds) {
    LAS unsigned char* vl = lds + C.wave * (2 * fa::VBUF);
    for (int pid = C.gw; pid < BATCH * NH * 32; pid += C.ngw) {
        const int bh = pid >> 5, sidx = pid & 31;
        fa::mla_item(C.Q, C.KV, C.KR, C.OAB, bh >> 3, bh & 7, 63 - sidx, vl, lane_id());
        fa::mla_item(C.Q, C.KV, C.KR, C.OAB, bh >> 3, bh & 7, sidx, vl, lane_id());
    }
}
__device__ __forceinline__ void p3_fast_dil_only(Ctx& C, LAS unsigned char* lds) {
    LAS unsigned char* vl = lds + C.wave * (2 * fa::VBUF);
    for (int pid = C.gw; pid < BATCH * NH * 32; pid += C.ngw) {
        const int bh = pid >> 5, r = (pid >> 3) & 3, sidx = pid & 7;
        fa::dil_item(C.QKVD, C.OAB, bh >> 3, bh & 7, r, 15 - sidx, vl, lane_id());
        fa::dil_item(C.QKVD, C.OAB, bh >> 3, bh & 7, r, sidx, vl, lane_id());
    }
}
__device__ __forceinline__ void p3_fast(Ctx& C, LAS unsigned char* lds) {
    LAS unsigned char* vl = lds + C.wave * (2 * fa::VBUF);
    for (int pid = blockIdx.x; pid < BATCH * NH * 4; pid += gridDim.x) {
        const int bh = pid >> 2, sidx = pid & 3;
        fa::mla_unit(C.Q, C.KV, C.KR, C.OAB, bh >> 3, bh & 7, 7 - sidx, lds, C.wave, lane_id());
        fa::mla_unit(C.Q, C.KV, C.KR, C.OAB, bh >> 3, bh & 7, sidx, lds, C.wave, lane_id());
    }
    for (int pid = C.gw; pid < BATCH * NH * 32; pid += C.ngw) {
        const int bh = pid >> 5, r = (pid >> 3) & 3, sidx = pid & 7;
        fa::dil_item(C.QKVD, C.OAB, bh >> 3, bh & 7, r, 15 - sidx, vl, lane_id());
        fa::dil_item(C.QKVD, C.OAB, bh >> 3, bh & 7, r, sidx, vl, lane_id());
    }
}

#ifndef F_IN
#define F_IN 1
#endif
#ifndef F_UP
#define F_UP 1
#endif
#ifndef F_MIX
#define F_MIX 1
#endif
#ifndef F_OUT
#define F_OUT 1
#endif
#ifndef F_FF1
#define F_FF1 1
#endif
#ifndef F_FF2
#define F_FF2 1
#endif
#ifndef F_ATTN
#define F_ATTN 1
#endif
#ifndef F_PROBE
#define F_PROBE 0
#endif
__device__ __forceinline__ void kr_rope(Ctx& C) {
    for (long idx = gt_id(); idx < (long)M * 16; idx += C.ngt) {
        const int m = (int)(idx >> 4), j = (int)(idx & 15), pos = m % SEQ;
        const float c = C.ROPET[2 * (pos * 16 + j)], s = C.ROPET[2 * (pos * 16 + j) + 1];
        const float t1 = bf2f(C.PS[(size_t)m * PSW + 640 + j]), t2 = bf2f(C.PS[(size_t)m * PSW + 656 + j]);
        C.KR[(size_t)m * 32 + j] = (bf16_t)f2bf(t1 * c - t2 * s); C.KR[(size_t)m * 32 + 16 + j] = (bf16_t)f2bf(t1 * s + t2 * c);
    }
}

#define XB_TMO      128
#define XB_XCNT(j)  (256  + 64 * (j))
#define XB_XSUB(j)  (1280 + 64 * (j))
#define XB_XGEN(j)  (2304 + 64 * (j))
#define XB_TOP      3328
#define XB_TOPGEN   3392
#define XCD_BAR_WORDS 3456
#define XB_SPIN_CAP (1u << 22)
__device__ __forceinline__ unsigned xb_ld(unsigned* p)              { return __hip_atomic_load(p, __ATOMIC_RELAXED, __HIP_MEMORY_SCOPE_AGENT); }
__device__ __forceinline__ unsigned xb_add(unsigned* p, unsigned v) { return __hip_atomic_fetch_add(p, v, __ATOMIC_RELAXED, __HIP_MEMORY_SCOPE_AGENT); }
__device__ __forceinline__ unsigned xb_xcc_id() { return (unsigned)__builtin_amdgcn_s_getreg((3 << 11) | 20) & 0xFu; }
#define XB_SPIN(cond, bar) do { unsigned _sp = 0; while (cond) { __builtin_amdgcn_s_sleep(1); \
    if ((++_sp & 255u) == 0u) { if (xb_ld(&(bar)[XB_TMO])) break; if (_sp > XB_SPIN_CAP) { atomicAdd(&(bar)[XB_TMO], 1u); break; } } } } while (0)
struct XcdBarrier { unsigned* bar; unsigned x; volatile LAS unsigned* st; };
__device__ __forceinline__ XcdBarrier xcd_barrier_post(unsigned* bar, volatile LAS unsigned* st) {
    XcdBarrier b; b.bar = bar; b.x = xb_xcc_id(); b.st = st;
    if (threadIdx.x == 0) (void)xb_add(&bar[XB_XCNT(b.x)], 1u);
    return b;
}
__device__ __forceinline__ void xcd_barrier_complete(unsigned* bar, unsigned x, unsigned& nloc, unsigned& nx) {
    const unsigned G = gridDim.x * gridDim.y * gridDim.z;
    unsigned sum, cnt, mine, sp = 0u;
    for (;;) {
        sum = 0u; cnt = 0u; mine = 0u;
#pragma unroll
        for (unsigned j = 0; j < 16; ++j) { const unsigned c = xb_ld(&bar[XB_XCNT(j)]); sum += c; cnt += (c > 0u) ? 1u : 0u; mine = (j == x) ? c : mine; }
        if (sum == G) break;
        __builtin_amdgcn_s_sleep(1);
        if ((++sp & 255u) == 0u) { if (xb_ld(&bar[XB_TMO])) break; if (sp > XB_SPIN_CAP) { atomicAdd(&bar[XB_TMO], 1u); break; } }
    }
    nloc = mine > 0u ? mine : 1u; nx = cnt > 0u ? cnt : 1u;
}
__device__ __forceinline__ void xcd_barrier(const XcdBarrier& b) {
    asm volatile("s_waitcnt vmcnt(0)" ::: "memory");
    __syncthreads();
    if (threadIdx.x == 0) {
        unsigned* bar = b.bar;
        __builtin_amdgcn_s_waitcnt(0);
        unsigned nloc = b.st[0], nx = b.st[1];
        if (nloc == 0u) { xcd_barrier_complete(bar, b.x, nloc, nx); b.st[0] = nloc; b.st[1] = nx; }
        const unsigned old = xb_add(&bar[XB_XSUB(b.x)], 1u);
        const unsigned gen = old / nloc;
        if (old + 1u == (gen + 1u) * nloc) {
            __builtin_amdgcn_fence(__ATOMIC_RELEASE, "agent");
            asm volatile("s_waitcnt vmcnt(0)" ::: "memory");
            const unsigned og = xb_add(&bar[XB_TOP], 1u);
            const unsigned tg = og / nx;
            if (og + 1u == (tg + 1u) * nx) xb_add(&bar[XB_TOPGEN], 1u);
            else XB_SPIN(xb_ld(&bar[XB_TOPGEN]) == tg, bar);
            __builtin_amdgcn_fence(__ATOMIC_ACQUIRE, "agent");
            xb_add(&bar[XB_XGEN(b.x)], 1u);
            asm volatile("s_waitcnt vmcnt(0)" ::: "memory");
        } else {
            XB_SPIN(xb_ld(&bar[XB_XGEN(b.x)]) == gen, bar);
            __builtin_amdgcn_fence(__ATOMIC_ACQUIRE, "agent");
            asm volatile("s_waitcnt vmcnt(0)" ::: "memory");
        }
    }
    __syncthreads();
}

constexpr int NTHREADS = 512;
constexpr int LDS_BYTES = 147456;
constexpr int NPHASES = 12;

__global__ void __launch_bounds__(NTHREADS, 2) fwd_megakernel(Args args) {
    extern __shared__ __attribute__((aligned(16))) unsigned char lds_raw[];
    LAS unsigned char* lds = (LAS unsigned char*)lds_raw;
    cg::grid_group grid = cg::this_grid();
    Ctx C;
    C.wave = __builtin_amdgcn_readfirstlane((int)threadIdx.x >> 6);
    C.gw = blockIdx.x * (NTHREADS / 64) + C.wave; C.ngw = gridDim.x * (NTHREADS / 64);
    C.ngt = (long)gridDim.x * NTHREADS;
    C.x = args.in[0]; C.w_in = args.in[1]; C.b_gate = args.in[2]; C.g_q_a = args.in[3]; C.w_uq = args.in[4]; C.g_kv_a = args.in[5]; C.w_ukv = args.in[6];
    C.w_o_mla = args.in[7]; C.w_o_dil = args.in[8]; C.w_out = args.in[9]; C.ln1_g = args.in[10]; C.ln1_b = args.in[11]; C.w_ff1 = args.in[12]; C.w_ff2 = args.in[13];
    C.ln2_g = args.in[14]; C.ln2_b = args.in[15]; C.out = args.out; C.ws = args.ws;
    unsigned char* ws = args.ws;
    C.WIN = (bf16_t*)(ws + WS_WIN); C.WUQ = (bf16_t*)(ws + WS_WUQ); C.WUKV = (bf16_t*)(ws + WS_WUKV); C.WOAB = (bf16_t*)(ws + WS_WOAB); C.WOUT = (bf16_t*)(ws + WS_WOUT);
    C.WFF1 = (bf16_t*)(ws + WS_WFF1); C.WFF2 = (bf16_t*)(ws + WS_WFF2); C.ROPET = (float*)(ws + WS_ROPE); C.SUMSQ = (float*)(ws + WS_SUMSQ);
    C.PS = (bf16_t*)(ws + WS_PS); C.QKVD = (bf16_t*)(ws + WS_QKVD); C.GATES = (bf16_t*)(ws + WS_GATES); C.XB = (bf16_t*)(ws + WS_XB); C.Q = C.XB; C.MIXIN = C.XB;
    C.KV = (bf16_t*)(ws + WS_KV); C.T = C.KV; C.HB = C.KV; C.OAB = (bf16_t*)(ws + WS_OAB); C.KR = (bf16_t*)(ws + WS_KR); C.HID = (bf16_t*)(ws + WS_HID);

    const int G = gridDim.x, cu = blockIdx.x;
    volatile LAS unsigned* misc = (volatile LAS unsigned*)(lds + 131072 + 320);
    if (threadIdx.x < 16) misc[threadIdx.x] = 0u;
    __syncthreads();
    XcdBarrier xbar = xcd_barrier_post((unsigned*)(args.ws) + 1024, misc + 8);
#if F_PROBE == 5
#define SYNC() do { xcd_barrier(xbar); xcd_barrier(xbar); } while (0)
#else
#define SYNC() xcd_barrier(xbar)
#endif
    p0_prologue(C, lds);
#if F_PROBE == 6
    p0_prologue(C, lds);
#endif
    grid.sync();
#if F_IN
    { pg8::Gemm g{C.XB, C.WIN, DM, DM, DM}; pg8::StaticOrder S; S.init(M, NIN, G, cu);
      pg8::EpiIn E{C.PS, C.QKVD, C.GATES, C.b_gate, C.SUMSQ, true};
      pg8::gemm_phase<pg8::EpiIn, pg8::StaticOrder, true>(lds, g, S, E);
#if F_PROBE == 4
      pg8::EpiIn E2{C.PS, C.QKVD, C.GATES, C.b_gate, C.SUMSQ, false};
      pg8::gemm_phase<pg8::EpiIn, pg8::StaticOrder, true>(lds, g, S, E2);
#endif
    }
    SYNC();
#else
    p1_naive(C); SYNC();
#endif
#if F_UP
#ifndef T_NOQ
    { pg8::Gemm g{C.PS, C.WUQ, QLORA, PSW, QLORA}; pg8::StaticOrder S; S.init(M, 768, G, cu);
      pg8::EpiQ E{C.Q, C.SUMSQ, C.ROPET};
      pg8::gemm_phase<pg8::EpiQ, pg8::StaticOrder, true>(lds, g, S, E); }
#endif
#ifndef T_NOKV
    { pg8::Gemm g{C.PS + QLORA, C.WUKV, KVLORA, PSW, KVLORA}; pg8::StaticOrder S; S.init(M, 1024, G, cu);
      pg8::EpiKV E{C.KV, C.SUMSQ};
      pg8::gemm_phase<pg8::EpiKV, pg8::StaticOrder, true>(lds, g, S, E); }
#endif
    kr_rope(C);
#if F_PROBE == 7
    { pg8::Gemm g{C.PS, C.WUQ, QLORA, PSW, QLORA}; pg8::StaticOrder S; S.init(M, 768, G, cu);
      pg8::EpiQ E{C.Q, C.SUMSQ, C.ROPET};
      pg8::gemm_phase<pg8::EpiQ, pg8::StaticOrder, true>(lds, g, S, E); }
    { pg8::Gemm g{C.PS + QLORA, C.WUKV, KVLORA, PSW, KVLORA}; pg8::StaticOrder S; S.init(M, 1024, G, cu);
      pg8::EpiKV E{C.KV, C.SUMSQ};
      pg8::gemm_phase<pg8::EpiKV, pg8::StaticOrder, true>(lds, g, S, E); }
    kr_rope(C);
#endif
    SYNC();
#else
    p2_naive(C); SYNC();
    p2b_naive_qrope(C); SYNC();
#endif
#if F_ATTN == 1
    p3_fast(C, lds);
#if F_PROBE == 1
    p3_fast_mla_only(C, lds);
#elif F_PROBE == 2
    p3_fast_dil_only(C, lds);
#endif
#elif F_ATTN == 2
    p3_naive_mla(C); p3_fast_dil_only(C, lds);
#elif F_ATTN == 3
    p3_fast_mla_only(C, lds); p3_naive_dil(C);
#else
    p3_naive_mla(C); p3_naive_dil(C);
#endif
    SYNC();
#if F_MIX
    { pg8::Gemm g{C.OAB, C.WOAB, 512, 512, 512}; pg8::PairOrder S; S.init(M, 1024, G, cu);
      pg8::EpiMix E{C.GATES, C.T, C.MIXIN};
      pg8::gemm_phase<pg8::EpiMix, pg8::PairOrder, true>(lds, g, S, E);
#if F_PROBE == 8
      pg8::gemm_phase<pg8::EpiMix, pg8::PairOrder, true>(lds, g, S, E);
#endif
    }
    SYNC();
#else
    p4_naive(C); SYNC();
    p4b_naive(C); SYNC();
#endif
#if F_OUT
    { pg8::Gemm g{C.MIXIN, C.WOUT, DM, DM, DM}; pg8::StaticOrder S; S.init(M, DM, G, cu);
      pg8::EpiRes E{C.x, C.out};
      pg8::gemm_phase<pg8::EpiRes, pg8::StaticOrder, true>(lds, g, S, E);
#if F_PROBE == 9
      pg8::gemm_phase<pg8::EpiRes, pg8::StaticOrder, true>(lds, g, S, E);
#endif
    }
    SYNC();
#else
    p5_naive(C); SYNC();
#endif
#if F_PROBE == 10
    ln_rows(C, C.ln1_g, C.ln1_b, C.PS, (float*)(C.ws + 100 * MiB));
#endif
    ln_rows(C, C.ln1_g, C.ln1_b, C.HB); SYNC();
#if F_FF1
    { pg8::Gemm g{C.HB, C.WFF1, DM, DM, DM}; pg8::StaticOrder S; S.init(M, DFF, G, cu);
      pg8::EpiSqRelu E{C.HID};
      pg8::gemm_phase<pg8::EpiSqRelu, pg8::StaticOrder, true>(lds, g, S, E);
#if F_PROBE == 3
      pg8::gemm_phase<pg8::EpiSqRelu, pg8::StaticOrder, true>(lds, g, S, E);
#endif
    }
    SYNC();
#else
    p7_naive(C); SYNC();
#endif
#if F_FF2
    { pg8::Gemm g{C.HID, C.WFF2, DFF, DFF, DFF}; pg8::StaticOrder S; S.init(M, DM, G, cu);
      pg8::EpiRes E{C.out, C.out};
#if F_PROBE == 11
      pg8::EpiRes E2{C.out, (float*)(C.ws + 306 * MiB)};
      pg8::gemm_phase<pg8::EpiRes, pg8::StaticOrder, true>(lds, g, S, E2);
#endif
      pg8::gemm_phase<pg8::EpiRes, pg8::StaticOrder, true>(lds, g, S, E); }
    SYNC();
#else
    p8_naive(C); SYNC();
#endif
#if F_PROBE == 10
    ln_rows(C, C.ln2_g, C.ln2_b, nullptr, (float*)(C.ws + 300 * MiB));
#endif
    ln_rows(C, C.ln2_g, C.ln2_b, nullptr);
#undef SYNC
}

extern "C" void kernel_launch(void* const* d_in, const int* in_sizes, int n_in, void* d_out, int out_size, void* d_ws, size_t ws_size, hipStream_t stream) {
    static int grid = 0;
    if (grid == 0) {
        if (n_in != 16 || in_sizes[0] != M * DM || out_size != M * DM || ws_size < WS_END) {
            fprintf(stderr, "kernel_launch: unexpected shapes: n_in %d in0 %d out %d ws %zu (need >= %zu)\n", n_in, n_in > 0 ? in_sizes[0] : -1, out_size, ws_size, (size_t)WS_END);
            grid = -1; return;
        }
        int dev = 0, cus = 0, per_cu = 0;
        (void)hipGetDevice(&dev);
        (void)hipDeviceGetAttribute(&cus, hipDeviceAttributeMultiprocessorCount, dev);
        (void)hipFuncSetAttribute((const void*)fwd_megakernel, hipFuncAttributeMaxDynamicSharedMemorySize, LDS_BYTES);
        (void)hipOccupancyMaxActiveBlocksPerMultiprocessor(&per_cu, (const void*)fwd_megakernel, NTHREADS, LDS_BYTES);
        if (per_cu < 1) { fprintf(stderr, "kernel_launch: occupancy query returned %d\n", per_cu); per_cu = 1; }
        (void)hipGetLastError();
        grid = cus * per_cu;
    }
    if (grid < 0) return;
    if (hipMemsetAsync(d_ws, 0, 65536, stream) != hipSuccess) { fprintf(stderr, "kernel_launch: memset of the barrier words failed\n"); return; }
    Args a{};
    for (int i = 0; i < 16; ++i) a.in[i] = (const float*)d_in[i];
    a.out = (float*)d_out; a.ws = (unsigned char*)d_ws; a.ph_lo = 0; a.ph_hi = NPHASES;
    void* kargs[] = {&a};
    hipError_t e = hipLaunchCooperativeKernel((const void*)fwd_megakernel, dim3(grid), dim3(NTHREADS), kargs, LDS_BYTES, stream);
    if (e != hipSuccess) fprintf(stderr, "cooperative launch failed: %s (grid %d)\n", hipGetErrorString(e), grid);
}
```
